# Optimizing an MI355X kernel written in HIP

```python
import math
import jax, jax.numpy as jnp
from jax import lax
import numpy as np

D_MODEL = 1024
BATCH = 8
SEQ = 2048
DEPTH = 4

GRID_W = 64
CTX_LEN = 256
EPS = 1e-6
N_MOD = 6
DA_HEADS = 4
DA_HEAD_DIM = 64
DA_WIDTH = DA_HEADS * 2 * DA_HEAD_DIM
ROPE_BASE = 10000.0
Q_BLOCK = 128
NA_HEADS = 8
NA_HEAD_DIM = 64
NA_WIDTH = NA_HEADS * NA_HEAD_DIM
NA_KH_MAX = 8
NA_KW = 16
FT_GROUPS = 4
FT_GROUP_DIM = 128
FT_WIDTH = FT_GROUPS * FT_GROUP_DIM
BRANCH_WIDTH = 512
N_BRANCHES = 3
IN_SPLITS = [DA_WIDTH, DA_WIDTH, DA_WIDTH, NA_WIDTH, NA_WIDTH, NA_WIDTH, FT_WIDTH, N_BRANCHES * D_MODEL]
IN_COLS = sum(IN_SPLITS)
N_EXPERTS = 32
TOP_K = 4
D_FF = D_MODEL
SWIGLU_LIMIT = 7.0
SWIGLU_ALPHA = 1.702
MOE_BLOCK = 256

kernel_name = "hybrid_diffusion_parallel_mixer_moe"


def rmsnorm(x, g):
    xf = x.astype(jnp.float32)
    xf = xf * lax.rsqrt(jnp.mean(xf * xf, axis=-1, keepdims=True) + EPS)
    return (xf * g.astype(jnp.float32)).astype(x.dtype)


def axial_rope_tables(n):
    t = jnp.arange(n)
    row = (t // GRID_W).astype(jnp.float32)
    col = (t % GRID_W).astype(jnp.float32)
    quarter = DA_HEAD_DIM // 4
    freqs = ROPE_BASE ** (-jnp.arange(quarter, dtype=jnp.float32) / quarter)
    ang = jnp.stack([row[:, None] * freqs, col[:, None] * freqs], axis=1)
    return jnp.cos(ang), jnp.sin(ang)


def apply_axial_rope(x, cos, sin):
    xs = x.astype(jnp.float32).reshape(x.shape[:-1] + (2, 2, x.shape[-1] // 4))
    x1, x2 = xs[..., 0, :], xs[..., 1, :]
    c = cos[None, :, None, None]
    s = sin[None, :, None, None]
    out = jnp.stack([x1 * c - x2 * s, x1 * s + x2 * c], axis=-2)
    return out.reshape(x.shape).astype(x.dtype)


def diff_attend(q, k, v, lam, subln_g, lam_init):
    s = jnp.einsum('bqhmd,bkhmd->bhmqk', q, k).astype(jnp.float32) * (DA_HEAD_DIM ** -0.5)
    p = jax.nn.softmax(s, axis=-1)
    a = p[:, :, 0] - lam * p[:, :, 1]
    o = jnp.einsum('bhqk,bkhe->bqhe', a.astype(v.dtype), v)
    o = rmsnorm(o, subln_g) * (1.0 - lam_init)
    return o.reshape(o.shape[0], o.shape[1], DA_WIDTH)


def diff_attention_latent(q, k, v, lam, subln_g, lam_init):
    B, S = q.shape[0], q.shape[1]
    nb = S // Q_BLOCK
    qb = q.reshape(B, nb, Q_BLOCK, DA_HEADS, 2, DA_HEAD_DIM).swapaxes(0, 1)
    ob = lax.map(lambda qi: diff_attend(qi, k, v, lam, subln_g, lam_init), qb)
    return ob.swapaxes(0, 1).reshape(B, S, DA_WIDTH)


def neighbourhood_attention(q, k, v, k_ctx, v_ctx, rpb):
    B, S, H, d = q.shape
    rows = S // GRID_W
    kh = min(NA_KH_MAX, rows)
    r = jnp.arange(rows)
    row_start = jnp.clip(r - kh // 2, 0, rows - kh)
    key_rows = row_start[:, None] + jnp.arange(kh)[None, :]
    col = jnp.arange(GRID_W)
    col_start = jnp.clip(col - NA_KW // 2, 0, GRID_W - NA_KW)
    col_mask = (col[None, :] >= col_start[:, None]) & (col[None, :] < col_start[:, None] + NA_KW)
    qg = q.reshape(B, rows, GRID_W, H, d)
    kg = k.reshape(B, rows, GRID_W, H, d)[:, key_rows]
    vg = v.reshape(B, rows, GRID_W, H, d)[:, key_rows]
    scale = d ** -0.5
    s_nb = jnp.einsum('brqhd,brjkhd->brhqjk', qg, kg).astype(jnp.float32) * scale
    dr = key_rows - r[:, None] + NA_KH_MAX - 1
    dc = jnp.clip(col[None, :] - col[:, None], 1 - NA_KW, NA_KW - 1) + NA_KW - 1
    bias = rpb.astype(jnp.float32)[:, dr[:, :, None, None], dc[None, None]]
    s_nb = s_nb + bias.transpose(1, 0, 3, 2, 4)[None]
    s_nb = jnp.where(col_mask[:, None, :], s_nb, -jnp.inf)
    s_ctx = jnp.einsum('brqhd,bkhd->brhqk', qg, k_ctx).astype(jnp.float32) * scale
    n_nb = kh * GRID_W
    s_all = jnp.concatenate([s_nb.reshape(B, rows, H, GRID_W, n_nb), s_ctx], axis=-1)
    p = jax.nn.softmax(s_all, axis=-1).astype(v.dtype)
    p_nb = p[..., :n_nb].reshape(B, rows, H, GRID_W, kh, GRID_W)
    p_ctx = p[..., n_nb:]
    o = (jnp.einsum('brhqjk,brjkhd->brqhd', p_nb, vg)
         + jnp.einsum('brhqk,bkhd->brqhd', p_ctx, v_ctx))
    return o.reshape(B, S, H * d)


def context_attention(q, k, v):
    s = jnp.einsum('bqhd,bkhd->bhqk', q, k).astype(jnp.float32) * (q.shape[-1] ** -0.5)
    p = jax.nn.softmax(s, axis=-1).astype(v.dtype)
    o = jnp.einsum('bhqk,bkhd->bqhd', p, v)
    return o.reshape(q.shape[0], q.shape[1], -1)


def fourier_mix(u):
    B, n, _ = u.shape
    ug = u.astype(jnp.float32).reshape(B, n, FT_GROUPS, FT_GROUP_DIM)
    f = jnp.fft.fftn(ug, axes=(1, 3), norm='ortho').real
    return f.reshape(B, n, FT_WIDTH).astype(u.dtype)


def merge_branches(oa, ob, oc, gate_logits, w_branch_l, w_out_l):
    o = jnp.stack([oa, ob, oc], axis=2)
    proj = jnp.einsum('bnie,ied->bnid', o, w_branch_l)
    g = jax.nn.sigmoid(gate_logits.reshape(gate_logits.shape[:-1] + (N_BRANCHES, D_MODEL)))
    return jnp.sum(g * proj, axis=2) @ w_out_l


def moe_ffn(h, w_router, b_router, w_gate_up, b_gate_up, w_down, b_down):
    lead = h.shape[:-1]
    hf = h.reshape(-1, D_MODEL)
    T = hf.shape[0]
    logits = (hf @ w_router + b_router).astype(jnp.float32)
    top_val, top_idx = lax.top_k(logits, TOP_K)
    top_w = jax.nn.softmax(top_val, axis=-1).astype(h.dtype)
    n_assign = T * TOP_K
    flat_e = top_idx.reshape(-1)
    order = jnp.argsort(flat_e)
    sorted_e = flat_e[order]
    sorted_tok = (order // TOP_K).astype(jnp.int32)
    sorted_w = top_w.reshape(-1)[order]
    counts = jnp.bincount(flat_e, length=N_EXPERTS)
    padded = (counts + MOE_BLOCK - 1) // MOE_BLOCK * MOE_BLOCK
    pad_end = jnp.cumsum(padded)
    pad_start = pad_end - padded
    grp_start = jnp.cumsum(counts) - counts
    slot = pad_start[sorted_e] + jnp.arange(n_assign) - grp_start[sorted_e]
    n_blocks = -(-n_assign // MOE_BLOCK) + N_EXPERTS
    n_slots = n_blocks * MOE_BLOCK
    slot_tok = jnp.full((n_slots,), T, jnp.int32).at[slot].set(sorted_tok)
    slot_w = jnp.zeros((n_slots,), h.dtype).at[slot].set(sorted_w)
    block_e = jnp.minimum(jnp.searchsorted(pad_end, jnp.arange(n_blocks) * MOE_BLOCK, side='right'),
                          N_EXPERTS - 1)
    h_pad = jnp.concatenate([hf, jnp.zeros((1, D_MODEL), h.dtype)], axis=0)
    xb = h_pad[slot_tok].reshape(n_blocks, MOE_BLOCK, D_MODEL)

    def expert_block(args):
        xe, e = args
        gu = xe @ w_gate_up[e] + b_gate_up[e]
        gate = jnp.minimum(gu[:, :D_FF], SWIGLU_LIMIT)
        up = jnp.clip(gu[:, D_FF:], -SWIGLU_LIMIT, SWIGLU_LIMIT)
        act = gate * jax.nn.sigmoid(SWIGLU_ALPHA * gate) * (up + 1.0)
        return act @ w_down[e] + b_down[e]

    yb = lax.map(expert_block, (xb, block_e)).reshape(n_slots, D_MODEL)
    out = jnp.zeros((T + 1, D_MODEL), h.dtype).at[slot_tok].add(yb * slot_w[:, None])
    return out[:T].reshape(lead + (D_MODEL,))


def setup_inputs(seed: int = 0) -> dict:
    key = jax.random.key(seed)
    ks = jax.random.split(key, 24)
    f32 = jnp.float32
    nrm = lambda k, shape, s: (jax.random.normal(k, shape, f32) * s)
    D = D_MODEL
    return {
        'x': nrm(ks[0], (BATCH, SEQ, D), 1.0),
        'c': nrm(ks[1], (BATCH, D), 1.0),
        'ctx': nrm(ks[2], (BATCH, CTX_LEN, D), 1.0),
        'c_ctx': nrm(ks[3], (D,), 1.0),
        'w_mod': nrm(ks[4], (DEPTH, D, N_MOD * D), 0.5 * D ** -0.5),
        'b_mod': nrm(ks[5], (DEPTH, N_MOD * D), 0.02),
        'norm_mix_g': 1.0 + nrm(ks[6], (DEPTH, D), 0.02),
        'norm_ffn_g': 1.0 + nrm(ks[7], (DEPTH, D), 0.02),
        'w_in': nrm(ks[8], (DEPTH, D, IN_COLS), D ** -0.5),
        'da_lambda': nrm(ks[9], (DEPTH, 4, DA_HEAD_DIM), 0.1),
        'da_subln_g': 1.0 + nrm(ks[10], (DEPTH, 2 * DA_HEAD_DIM), 0.02),
        'na_rpb': nrm(ks[11], (DEPTH, NA_HEADS, 2 * NA_KH_MAX - 1, 2 * NA_KW - 1), 0.1),
        'w_branch': nrm(ks[12], (DEPTH, N_BRANCHES, BRANCH_WIDTH, D), BRANCH_WIDTH ** -0.5),
        'w_out': nrm(ks[13], (DEPTH, D, D), D ** -0.5),
        'w_router': nrm(ks[14], (DEPTH, D, N_EXPERTS), D ** -0.5),
        'b_router': nrm(ks[15], (DEPTH, N_EXPERTS), 0.01),
        'w_gate_up': nrm(ks[16], (DEPTH, N_EXPERTS, D, 2 * D_FF), D ** -0.5),
        'b_gate_up': nrm(ks[17], (DEPTH, N_EXPERTS, 2 * D_FF), 0.02),
        'w_down': nrm(ks[18], (DEPTH, N_EXPERTS, D_FF, D), D_FF ** -0.5),
        'b_down': nrm(ks[19], (DEPTH, N_EXPERTS, D), 0.02),
        'final_g': 1.0 + nrm(ks[20], (D,), 0.02),
    }


def reference(x, c, ctx, c_ctx, w_mod, b_mod, norm_mix_g, norm_ffn_g, w_in, da_lambda,
              da_subln_g, na_rpb, w_branch, w_out, w_router, b_router, w_gate_up,
              b_gate_up, w_down, b_down, final_g):
    B, S, _ = x.shape
    C = ctx.shape[1]
    split_pts = list(np.cumsum(IN_SPLITS)[:-1])
    cos, sin = axial_rope_tables(S)
    silu_c = jax.nn.silu(c)
    silu_cc = jax.nn.silu(c_ctx)[None]
    y = ctx
    for l in range(DEPTH):
        last = l == DEPTH - 1
        lam_init = 0.8 - 0.6 * math.exp(-0.3 * l)
        lq1, lk1, lq2, lk2 = [da_lambda[l, i].astype(jnp.float32) for i in range(4)]
        lam = jnp.exp(jnp.sum(lq1 * lk1)) - jnp.exp(jnp.sum(lq2 * lk2)) + lam_init
        sh1x, sc1x, g1x, sh2x, sc2x, g2x = [m[:, None] for m in jnp.split(silu_c @ w_mod[l] + b_mod[l], N_MOD, axis=-1)]
        sh1y, sc1y, g1y, sh2y, sc2y, g2y = [m[:, None] for m in jnp.split(silu_cc @ w_mod[l] + b_mod[l], N_MOD, axis=-1)]

        hx = rmsnorm(x, norm_mix_g[l]) * (1.0 + sc1x) + sh1x
        hy = rmsnorm(y, norm_mix_g[l]) * (1.0 + sc1y) + sh1y
        qa_x, ka_x, va_x, qn_x, kn_x, vn_x, f_x, gt_x = jnp.split(hx @ w_in[l], split_pts, axis=-1)
        qa_y, ka_y, va_y, qn_y, kn_y, vn_y, f_y, gt_y = jnp.split(hy @ w_in[l], split_pts, axis=-1)

        qa_x = apply_axial_rope(qa_x.reshape(B, S, DA_HEADS, 2, DA_HEAD_DIM), cos, sin)
        ka_x = apply_axial_rope(ka_x.reshape(B, S, DA_HEADS, 2, DA_HEAD_DIM), cos, sin)
        ka_y = ka_y.reshape(B, C, DA_HEADS, 2, DA_HEAD_DIM)
        va_x = va_x.reshape(B, S, DA_HEADS, 2 * DA_HEAD_DIM)
        va_y = va_y.reshape(B, C, DA_HEADS, 2 * DA_HEAD_DIM)
        k_cat = jnp.concatenate([ka_x, ka_y], axis=1)
        v_cat = jnp.concatenate([va_x, va_y], axis=1)
        oa_x = diff_attention_latent(qa_x, k_cat, v_cat, lam, da_subln_g[l], lam_init)

        kn_y = kn_y.reshape(B, C, NA_HEADS, NA_HEAD_DIM)
        vn_y = vn_y.reshape(B, C, NA_HEADS, NA_HEAD_DIM)
        ob_x = neighbourhood_attention(qn_x.reshape(B, S, NA_HEADS, NA_HEAD_DIM),
                                       kn_x.reshape(B, S, NA_HEADS, NA_HEAD_DIM),
                                       vn_x.reshape(B, S, NA_HEADS, NA_HEAD_DIM),
                                       kn_y, vn_y, na_rpb[l])

        oc_x = fourier_mix(f_x)
        mix_x = merge_branches(oa_x, ob_x, oc_x, gt_x, w_branch[l], w_out[l])

        if not last:
            oa_y = diff_attend(qa_y.reshape(B, C, DA_HEADS, 2, DA_HEAD_DIM), ka_y, va_y,
                               lam, da_subln_g[l], lam_init)
            ob_y = context_attention(qn_y.reshape(B, C, NA_HEADS, NA_HEAD_DIM), kn_y, vn_y)
            oc_y = fourier_mix(f_y)
            mix_y = merge_branches(oa_y, ob_y, oc_y, gt_y, w_branch[l], w_out[l])
            y = y + g1y * mix_y
            hy2 = rmsnorm(y, norm_ffn_g[l]) * (1.0 + sc2y) + sh2y
            y = y + g2y * moe_ffn(hy2, w_router[l], b_router[l], w_gate_up[l], b_gate_up[l],
                                  w_down[l], b_down[l])

        x = x + g1x * mix_x
        hx2 = rmsnorm(x, norm_ffn_g[l]) * (1.0 + sc2x) + sh2x
        x = x + g2x * moe_ffn(hx2, w_router[l], b_router[l], w_gate_up[l], b_gate_up[l],
                              w_down[l], b_down[l])
    return rmsnorm(x, final_g)
```

```cpp
#include <hip/hip_runtime.h>
#include <hip/hip_bf16.h>
#include <stdint.h>
#include <stdio.h>

typedef unsigned short bf16_t;
__device__ __forceinline__ float bf2f(bf16_t v) { return __uint_as_float(((unsigned)v) << 16); }
__device__ __forceinline__ bf16_t f2bf(float f) { unsigned u = __float_as_uint(f); u += 0x7FFFu + ((u >> 16) & 1u); return (bf16_t)(u >> 16); }

constexpr int D = 1024, NB = 8, SEQ = 2048, CTX = 256, TX = NB * SEQ, TY = NB * CTX, T = TX + TY, DEPTH = 4;
constexpr int NMOD = 6 * D, INC = 6656, NEXP = 32, CAP = T;
constexpr float EPS = 1e-6f;

struct P {
    const float *x, *c, *ctx, *c_ctx, *w_mod, *b_mod, *nmg, *nfg, *w_in, *da_lambda, *da_subln_g, *na_rpb, *w_branch, *w_out, *w_router, *b_router, *w_gu, *b_gu, *w_dn, *b_dn, *final_g;
    float* out;
    float *X, *MOD, *LAM, *F, *Mf, *ROPE, *SROWW;
    bf16_t *H1, *QKV, *G, *FtX, *FtY, *CSX, *CSY, *O, *Mg, *H2S, *ACT, *YS;
    int *CNT, *ROWIDX;
};

__device__ __forceinline__ float wave_sum(float v) { for (int o = 32; o; o >>= 1) v += __shfl_xor(v, o); return v; }
__device__ __forceinline__ float wave_max(float v) { for (int o = 32; o; o >>= 1) v = fmaxf(v, __shfl_xor(v, o)); return v; }
__device__ __forceinline__ int modidx(int row) { return row < TX ? row / SEQ : NB; }

__global__ __launch_bounds__(256) void k_mod(P p) {
    __shared__ float sc[9][1024];
    __shared__ float red[4][9][64];
    const int t = threadIdx.x, l = blockIdx.y, n = blockIdx.x * 64 + (t & 63), kg = t >> 6;
    for (int i = t; i < 9 * 1024; i += 256) { int r = i >> 10, k = i & 1023; float v = r < 8 ? p.c[r * 1024 + k] : p.c_ctx[k]; sc[r][k] = v / (1.f + expf(-v)); }
    __syncthreads();
    float acc[9];
#pragma unroll
    for (int r = 0; r < 9; ++r) acc[r] = 0.f;
    const float* w = p.w_mod + (size_t)l * 1024 * NMOD + n;
#pragma unroll 8
    for (int k = kg * 256; k < kg * 256 + 256; ++k) { float wv = w[(size_t)k * NMOD];
#pragma unroll
        for (int r = 0; r < 9; ++r) acc[r] += sc[r][k] * wv; }
#pragma unroll
    for (int r = 0; r < 9; ++r) red[kg][r][t & 63] = acc[r];
    __syncthreads();
    for (int i = t; i < 9 * 64; i += 256) { int r = i >> 6, c = i & 63; int nn = blockIdx.x * 64 + c;
        p.MOD[(size_t)(l * 9 + r) * NMOD + nn] = red[0][r][c] + red[1][r][c] + red[2][r][c] + red[3][r][c] + p.b_mod[l * NMOD + nn]; }
}
__global__ void k_lam(P p) {
    int l = threadIdx.x >> 6, lane = threadIdx.x & 63;
    const float* d = p.da_lambda + l * 256;
    float a = wave_sum(d[lane] * d[64 + lane]), b = wave_sum(d[128 + lane] * d[192 + lane]);
    if (lane == 0) p.LAM[l] = expf(a) - expf(b) + (0.8f - 0.6f * expf(-0.3f * (float)l));
}
__global__ void k_rope_tab(P p) {
    int idx = blockIdx.x * 256 + threadIdx.x; if (idx >= SEQ * 32) return;
    int s = idx >> 5, j = idx & 31, axis = j >> 4, i = j & 15;
    float pos = axis == 0 ? (float)(s / 64) : (float)(s % 64);
    float fr = powf(10000.f, -(float)i / 16.f); float a = pos * fr;
    p.ROPE[idx] = cosf(a); p.ROPE[SEQ * 32 + idx] = sinf(a);
}
__global__ void k_dft_tab(P p) {
    size_t idx = (size_t)blockIdx.x * 256 + threadIdx.x;
    if (idx < (size_t)2048 * 4096) { int r = (int)(idx >> 12), k = (int)(idx & 4095); int n = k & 2047; int m = (r * n) & 2047; float a = (float)m / 1024.f;
        p.CSX[idx] = f2bf(k < 2048 ? cospif(a) : -sinpif(a)); }
    if (idx < (size_t)256 * 512) { int r = (int)(idx >> 9), k = (int)(idx & 511); int n = k & 255; int m = (r * n) & 255; float a = (float)m / 128.f;
        p.CSY[idx] = f2bf(k < 256 ? cospif(a) : -sinpif(a)); }
}
__global__ void k_initx(P p) {
    size_t i = (size_t)blockIdx.x * 256 + threadIdx.x; if (i >= (size_t)T * 256) return;
    const size_t nx = (size_t)TX * 256;
    ((float4*)p.X)[i] = i < nx ? ((const float4*)p.x)[i] : ((const float4*)p.ctx)[i - nx];
}

__global__ __launch_bounds__(256) void k_norm1(P p, int l) {
    const int row = blockIdx.x * 4 + (threadIdx.x >> 6), lane = threadIdx.x & 63;
    const float4* xr = (const float4*)(p.X + (size_t)row * D);
    float4 v[4]; float ss = 0.f;
#pragma unroll
    for (int i = 0; i < 4; ++i) { v[i] = xr[lane + 64 * i]; ss += v[i].x * v[i].x + v[i].y * v[i].y + v[i].z * v[i].z + v[i].w * v[i].w; }
    ss = wave_sum(ss); const float rs = rsqrtf(ss * (1.f / D) + EPS);
    const float* md = p.MOD + (size_t)(l * 9 + modidx(row)) * NMOD; const float* g = p.nmg + l * D;
#pragma unroll
    for (int i = 0; i < 4; ++i) { const int c = (lane + 64 * i) * 4; const float4 gg = *(const float4*)(g + c), sh = *(const float4*)(md + c), sc = *(const float4*)(md + D + c);
        ushort4 o; o.x = f2bf(v[i].x * rs * gg.x * (1.f + sc.x) + sh.x); o.y = f2bf(v[i].y * rs * gg.y * (1.f + sc.y) + sh.y); o.z = f2bf(v[i].z * rs * gg.z * (1.f + sc.z) + sh.z); o.w = f2bf(v[i].w * rs * gg.w * (1.f + sc.w) + sh.w);
        *(ushort4*)(p.H1 + (size_t)row * D + c) = o; }
}
__global__ __launch_bounds__(256) void k_norm2_route(P p, int l) {
    __shared__ float hs[4][1024];
    const int w = threadIdx.x >> 6, row = blockIdx.x * 4 + w, lane = threadIdx.x & 63;
    const float4* xr = (const float4*)(p.X + (size_t)row * D);
    float4 v[4]; float ss = 0.f;
#pragma unroll
    for (int i = 0; i < 4; ++i) { v[i] = xr[lane + 64 * i]; ss += v[i].x * v[i].x + v[i].y * v[i].y + v[i].z * v[i].z + v[i].w * v[i].w; }
    ss = wave_sum(ss); const float rs = rsqrtf(ss * (1.f / D) + EPS);
    const float* md = p.MOD + (size_t)(l * 9 + modidx(row)) * NMOD; const float* g = p.nfg + l * D;
    ushort4 hb[4];
#pragma unroll
    for (int i = 0; i < 4; ++i) { const int c = (lane + 64 * i) * 4; const float4 gg = *(const float4*)(g + c), sh = *(const float4*)(md + 3 * D + c), sc = *(const float4*)(md + 4 * D + c);
        float4 h; h.x = v[i].x * rs * gg.x * (1.f + sc.x) + sh.x; h.y = v[i].y * rs * gg.y * (1.f + sc.y) + sh.y; h.z = v[i].z * rs * gg.z * (1.f + sc.z) + sh.z; h.w = v[i].w * rs * gg.w * (1.f + sc.w) + sh.w;
        *(float4*)(&hs[w][c]) = h; hb[i].x = f2bf(h.x); hb[i].y = f2bf(h.y); hb[i].z = f2bf(h.z); hb[i].w = f2bf(h.w); }
    __syncthreads();
    const int e = lane & 31, half = lane >> 5;
    const float* wr = p.w_router + (size_t)l * D * NEXP + e;
    float acc = 0.f;
#pragma unroll 8
    for (int k = half * 512; k < half * 512 + 512; ++k) acc += hs[w][k] * wr[(size_t)k * NEXP];
    acc += __shfl_xor(acc, 32);
    float logit = acc + p.b_router[l * NEXP + e];
    float tv[4]; int ti[4];
#pragma unroll
    for (int r = 0; r < 4; ++r) {
        float bv = logit; int bi = e;
        for (int o = 16; o; o >>= 1) { float ov = __shfl_xor(bv, o); int oi = __shfl_xor(bi, o); if (ov > bv || (ov == bv && oi < bi)) { bv = ov; bi = oi; } }
        tv[r] = bv; ti[r] = bi; if (e == bi) logit = -INFINITY;
    }
    float e1 = expf(tv[1] - tv[0]), e2 = expf(tv[2] - tv[0]), e3 = expf(tv[3] - tv[0]); float inv = 1.f / (1.f + e1 + e2 + e3);
    float wk[4] = {inv, e1 * inv, e2 * inv, e3 * inv};
    int myrow = 0;
    if (lane < 4) { int ee = ti[0]; float ww = wk[0];
        if (lane == 1) { ee = ti[1]; ww = wk[1]; } if (lane == 2) { ee = ti[2]; ww = wk[2]; } if (lane == 3) { ee = ti[3]; ww = wk[3]; }
        int pos = atomicAdd(&p.CNT[l * NEXP + ee], 1); myrow = ee * CAP + pos; p.ROWIDX[row * 4 + lane] = myrow; p.SROWW[myrow] = ww; }
#pragma unroll
    for (int k = 0; k < 4; ++k) { const int rr = __shfl(myrow, k); bf16_t* dst = p.H2S + (size_t)rr * D;
#pragma unroll
        for (int i = 0; i < 4; ++i) *(ushort4*)(dst + (lane + 64 * i) * 4) = hb[i]; }
}
__global__ __launch_bounds__(256) void k_combine(P p, int l) {
    const int row = blockIdx.x * 4 + (threadIdx.x >> 6), lane = threadIdx.x & 63;
    const float* md = p.MOD + (size_t)(l * 9 + modidx(row)) * NMOD + 5 * D;
    int ri[4];
#pragma unroll
    for (int k = 0; k < 4; ++k) ri[k] = p.ROWIDX[row * 4 + k];
#pragma unroll
    for (int i = 0; i < 4; ++i) { const int c = (lane + 64 * i) * 4; float4 s = {0.f, 0.f, 0.f, 0.f};
#pragma unroll
        for (int k = 0; k < 4; ++k) { const ushort4 y = *(const ushort4*)(p.YS + (size_t)ri[k] * D + c); s.x += bf2f(y.x); s.y += bf2f(y.y); s.z += bf2f(y.z); s.w += bf2f(y.w); }
        const float4 g2 = *(const float4*)(md + c); float4* xp = (float4*)(p.X + (size_t)row * D + c); float4 xv = *xp;
        xv.x += g2.x * s.x; xv.y += g2.y * s.y; xv.z += g2.z * s.z; xv.w += g2.w * s.w; *xp = xv; }
}
__global__ __launch_bounds__(256) void k_final(P p) {
    const int row = blockIdx.x * 4 + (threadIdx.x >> 6), lane = threadIdx.x & 63;
    const float4* xr = (const float4*)(p.X + (size_t)row * D);
    float4 v[4]; float ss = 0.f;
#pragma unroll
    for (int i = 0; i < 4; ++i) { v[i] = xr[lane + 64 * i]; ss += v[i].x * v[i].x + v[i].y * v[i].y + v[i].z * v[i].z + v[i].w * v[i].w; }
    ss = wave_sum(ss); const float rs = rsqrtf(ss * (1.f / D) + EPS);
#pragma unroll
    for (int i = 0; i < 4; ++i) { const int c = (lane + 64 * i) * 4; const float4 gg = *(const float4*)(p.final_g + c);
        float4 o; o.x = v[i].x * rs * gg.x; o.y = v[i].y * rs * gg.y; o.z = v[i].z * rs * gg.z; o.w = v[i].w * rs * gg.w;
        *(float4*)(p.out + (size_t)row * D + c) = o; }
}

template <bool BT, bool DUAL, class F>
__global__ __launch_bounds__(256) void nv_gemm(F f, int K) {
    __shared__ float As[16][68], Bs[16][68], Bs2[DUAL ? 16 : 1][68];
    const int z = blockIdx.z, M = f.M(z);
    const int m0 = blockIdx.y * 64, n0 = blockIdx.x * 64;
    if (m0 >= M) return;
    const int t = threadIdx.x, tx = t & 15, ty = t >> 4;
    float acc[4][4], acc2[4][4];
#pragma unroll
    for (int i = 0; i < 4; ++i)
#pragma unroll
        for (int j = 0; j < 4; ++j) { acc[i][j] = 0.f; acc2[i][j] = 0.f; }
    for (int k0 = 0; k0 < K; k0 += 16) {
        { const int r = t >> 2, kk = (t & 3) * 4, m = m0 + r;
#pragma unroll
          for (int i = 0; i < 4; ++i) As[kk + i][r] = (m < M) ? f.a(z, m, k0 + kk + i) : 0.f; }
        if (BT) { const int kk = t & 15, nn = (t >> 4) * 4;
#pragma unroll
          for (int i = 0; i < 4; ++i) { Bs[kk][nn + i] = f.b(z, k0 + kk, n0 + nn + i); if (DUAL) Bs2[kk][nn + i] = f.b2(z, k0 + kk, n0 + nn + i); } }
        else { const int kk = t >> 4, nn = (t & 15) * 4;
#pragma unroll
          for (int i = 0; i < 4; ++i) { Bs[kk][nn + i] = f.b(z, k0 + kk, n0 + nn + i); if (DUAL) Bs2[kk][nn + i] = f.b2(z, k0 + kk, n0 + nn + i); } }
        __syncthreads();
#pragma unroll
        for (int kk = 0; kk < 16; ++kk) { float a[4], b[4], b2[4];
#pragma unroll
            for (int i = 0; i < 4; ++i) { a[i] = As[kk][ty * 4 + i]; b[i] = Bs[kk][tx * 4 + i]; b2[i] = DUAL ? Bs2[kk][tx * 4 + i] : 0.f; }
#pragma unroll
            for (int i = 0; i < 4; ++i)
#pragma unroll
                for (int j = 0; j < 4; ++j) { acc[i][j] += a[i] * b[j]; if (DUAL) acc2[i][j] += a[i] * b2[j]; } }
        __syncthreads();
    }
#pragma unroll
    for (int i = 0; i < 4; ++i) { const int m = m0 + ty * 4 + i; if (m < M) {
#pragma unroll
        for (int j = 0; j < 4; ++j) f.out(z, m, n0 + tx * 4 + j, acc[i][j], acc2[i][j]); } }
}

struct FInproj { P p; int l, pad;
    __device__ int M(int) const { return T; }
    __device__ float a(int, int m, int k) const { return bf2f(p.H1[(size_t)m * D + k]); }
    __device__ float b(int, int k, int n) const { return p.w_in[((size_t)l * D + k) * INC + n]; }
    __device__ float b2(int, int, int) const { return 0.f; }
    __device__ void out(int, int m, int n, float v, float) const {
        if (n < 3072) p.QKV[(size_t)m * 3072 + n] = f2bf(v);
        else if (n < 3584) p.F[(size_t)m * 512 + (n - 3072)] = v;
        else p.G[(size_t)m * 3072 + (n - 3584)] = f2bf(1.f / (1.f + expf(-v)));
    } };
struct FFourX { P p;
    __device__ int M(int) const { return SEQ; }
    __device__ float a(int, int m, int k) const { return bf2f(p.CSX[(size_t)m * 4096 + k]); }
    __device__ float b(int z, int k, int n) const { return bf2f(p.FtX[((size_t)z * 512 + n) * 4096 + k]); }
    __device__ float b2(int, int, int) const { return 0.f; }
    __device__ void out(int z, int m, int n, float v, float) const { p.O[((size_t)z * SEQ + m) * 1536 + 1024 + n] = f2bf(v * (1.f / 512.f)); } };
struct FFourY { P p;
    __device__ int M(int) const { return CTX; }
    __device__ float a(int, int m, int k) const { return bf2f(p.CSY[(size_t)m * 512 + k]); }
    __device__ float b(int z, int k, int n) const { return bf2f(p.FtY[((size_t)z * 512 + n) * 512 + k]); }
    __device__ float b2(int, int, int) const { return 0.f; }
    __device__ void out(int z, int m, int n, float v, float) const { p.O[((size_t)TX + z * CTX + m) * 1536 + 1024 + n] = f2bf(v * 0.005524271728f); } };
struct FMerge { P p; int l, i, Mr, pad;
    __device__ int M(int) const { return Mr; }
    __device__ float a(int, int m, int k) const { return bf2f(p.O[(size_t)m * 1536 + i * 512 + k]); }
    __device__ float b(int, int k, int n) const { return p.w_branch[(((size_t)l * 3 + i) * 512 + k) * D + n]; }
    __device__ float b2(int, int, int) const { return 0.f; }
    __device__ void out(int, int m, int n, float v, float) const { const float g = bf2f(p.G[(size_t)m * 3072 + i * D + n]); float* mf = p.Mf + (size_t)m * D + n;
        if (i == 0) *mf = g * v; else if (i == 1) *mf += g * v; else p.Mg[(size_t)m * D + n] = f2bf(*mf + g * v); } };
struct FOut { P p; int l, Mr;
    __device__ int M(int) const { return Mr; }
    __device__ float a(int, int m, int k) const { return bf2f(p.Mg[(size_t)m * D + k]); }
    __device__ float b(int, int k, int n) const { return p.w_out[((size_t)l * D + k) * D + n]; }
    __device__ float b2(int, int, int) const { return 0.f; }
    __device__ void out(int, int m, int n, float v, float) const { p.X[(size_t)m * D + n] += p.MOD[(size_t)(l * 9 + modidx(m)) * NMOD + 2 * D + n] * v; } };
struct FGateUp { P p; int l, pad;
    __device__ int M(int z) const { return p.CNT[l * NEXP + z]; }
    __device__ float a(int z, int m, int k) const { return bf2f(p.H2S[((size_t)z * CAP + m) * D + k]); }
    __device__ float b(int z, int k, int n) const { return p.w_gu[(((size_t)l * NEXP + z) * D + k) * 2048 + n]; }
    __device__ float b2(int z, int k, int n) const { return p.w_gu[(((size_t)l * NEXP + z) * D + k) * 2048 + 1024 + n]; }
    __device__ void out(int z, int m, int n, float v, float v2) const { const float* bb = p.b_gu + ((size_t)l * NEXP + z) * 2048;
        float gate = fminf(v + bb[n], 7.f), up = fminf(fmaxf(v2 + bb[1024 + n], -7.f), 7.f);
        float act = gate / (1.f + expf(-1.702f * gate)) * (up + 1.f);
        p.ACT[((size_t)z * CAP + m) * D + n] = f2bf(act); } };
struct FDown { P p; int l, pad;
    __device__ int M(int z) const { return p.CNT[l * NEXP + z]; }
    __device__ float a(int z, int m, int k) const { return bf2f(p.ACT[((size_t)z * CAP + m) * D + k]); }
    __device__ float b(int z, int k, int n) const { return p.w_dn[(((size_t)l * NEXP + z) * D + k) * D + n]; }
    __device__ float b2(int, int, int) const { return 0.f; }
    __device__ void out(int z, int m, int n, float v, float) const { const size_t r = (size_t)z * CAP + m;
        p.YS[r * D + n] = f2bf((v + p.b_dn[((size_t)l * NEXP + z) * D + n]) * p.SROWW[r]); } };

__global__ __launch_bounds__(256) void nv_rope(P p) {
    size_t idx = (size_t)blockIdx.x * 256 + threadIdx.x; if (idx >= (size_t)TX * 512) return;
    const int row = (int)(idx >> 9), r = (int)(idx & 511);
    const int which = r >> 8, sub = (r >> 5) & 7, axis = (r >> 4) & 1, i = r & 15, s = row % SEQ;
    bf16_t* q = p.QKV + (size_t)row * 3072 + which * 512 + sub * 64 + axis * 32 + i;
    const float c = p.ROPE[s * 32 + axis * 16 + i], sn = p.ROPE[SEQ * 32 + s * 32 + axis * 16 + i];
    const float x1 = bf2f(q[0]), x2 = bf2f(q[16]);
    q[0] = f2bf(x1 * c - x2 * sn); q[16] = f2bf(x1 * sn + x2 * c);
}
__global__ __launch_bounds__(256) void nv_chan_dft(P p) {
    size_t idx = (size_t)blockIdx.x * 256 + threadIdx.x; if (idx >= (size_t)T * 512) return;
    const int row = (int)(idx >> 9), col = (int)(idx & 511), g = col >> 7, j = col & 127;
    const float* f = p.F + (size_t)row * 512 + g * 128; float uc = 0.f, us = 0.f;
    for (int c = 0; c < 128; ++c) { const float a = (float)((j * c) & 127) / 64.f; const float v = f[c]; uc += v * cospif(a); us += v * sinpif(a); }
    if (row < TX) { const int b = row / SEQ, n = row % SEQ; bf16_t* d = p.FtX + ((size_t)b * 512 + col) * 4096; d[n] = f2bf(uc); d[2048 + n] = f2bf(us); }
    else { const int b = (row - TX) / CTX, n = (row - TX) % CTX; bf16_t* d = p.FtY + ((size_t)b * 512 + col) * 512; d[n] = f2bf(uc); d[256 + n] = f2bf(us); }
}
__device__ __forceinline__ float block_max256(float v, float* red) { v = wave_max(v); __syncthreads(); if ((threadIdx.x & 63) == 0) red[threadIdx.x >> 6] = v; __syncthreads(); return fmaxf(fmaxf(red[0], red[1]), fmaxf(red[2], red[3])); }
__device__ __forceinline__ float block_sum256(float v, float* red) { v = wave_sum(v); __syncthreads(); if ((threadIdx.x & 63) == 0) red[threadIdx.x >> 6] = v; __syncthreads(); return (red[0] + red[1]) + (red[2] + red[3]); }

__global__ __launch_bounds__(256) void nv_diffattn(P p, int l, int row0) {
    __shared__ float q[128]; __shared__ float s[2][2304]; __shared__ float red[4]; __shared__ float osum[2][128];
    const int row = row0 + blockIdx.x, h = blockIdx.y, t = threadIdx.x;
    const bool isx = row < TX; const int b = isx ? row / SEQ : (row - TX) / CTX; const int nk = isx ? SEQ + CTX : CTX;
    if (t < 128) q[t] = bf2f(p.QKV[(size_t)row * 3072 + h * 128 + t]);
    __syncthreads();
    float mx0 = -INFINITY, mx1 = -INFINITY;
    for (int k = t; k < nk; k += 256) { const size_t kr = isx ? (k < SEQ ? (size_t)b * SEQ + k : (size_t)TX + b * CTX + (k - SEQ)) : (size_t)TX + b * CTX + k;
        const bf16_t* kp = p.QKV + kr * 3072 + 512 + h * 128; float d0 = 0.f, d1 = 0.f;
        for (int d = 0; d < 64; ++d) { d0 += q[d] * bf2f(kp[d]); d1 += q[64 + d] * bf2f(kp[64 + d]); }
        d0 *= 0.125f; d1 *= 0.125f; s[0][k] = d0; s[1][k] = d1; mx0 = fmaxf(mx0, d0); mx1 = fmaxf(mx1, d1); }
    mx0 = block_max256(mx0, red); mx1 = block_max256(mx1, red);
    float l0 = 0.f, l1 = 0.f;
    for (int k = t; k < nk; k += 256) { float e0 = expf(s[0][k] - mx0), e1 = expf(s[1][k] - mx1); s[0][k] = e0; s[1][k] = e1; l0 += e0; l1 += e1; }
    l0 = block_sum256(l0, red); l1 = block_sum256(l1, red);
    const float lam = p.LAM[l], i0 = 1.f / l0, i1 = lam / l1;
    for (int k = t; k < nk; k += 256) s[0][k] = s[0][k] * i0 - s[1][k] * i1;
    __syncthreads();
    const int e = t & 127, half = t >> 7; float acc = 0.f;
    for (int k = half; k < nk; k += 2) { const size_t kr = isx ? (k < SEQ ? (size_t)b * SEQ + k : (size_t)TX + b * CTX + (k - SEQ)) : (size_t)TX + b * CTX + k;
        acc += s[0][k] * bf2f(p.QKV[kr * 3072 + 1024 + h * 128 + e]); }
    osum[half][e] = acc; __syncthreads();
    float o = osum[0][e] + osum[1][e];
    float ss = block_sum256(half == 0 ? o * o : 0.f, red);
    const float li = 0.8f - 0.6f * expf(-0.3f * (float)l);
    if (half == 0) p.O[(size_t)row * 1536 + h * 128 + e] = f2bf(o * rsqrtf(ss * (1.f / 128.f) + EPS) * p.da_subln_g[l * 128 + e] * (1.f - li));
}
__global__ __launch_bounds__(256) void nv_na(P p, int l, int row0) {
    __shared__ float q[64]; __shared__ float s[384]; __shared__ int kt[384]; __shared__ float red[4]; __shared__ float osum[4][64];
    const int row = row0 + blockIdx.x, h = blockIdx.y, t = threadIdx.x;
    const bool isx = row < TX; const int b = isx ? row / SEQ : (row - TX) / CTX; const int nk = isx ? 384 : 256;
    if (t < 64) q[t] = bf2f(p.QKV[(size_t)row * 3072 + 1536 + h * 64 + t]);
    __syncthreads();
    int r = 0, qc = 0, rs = 0, cs = 0;
    if (isx) { const int sq = row % SEQ; r = sq / 64; qc = sq % 64; rs = min(max(r - 4, 0), 24); cs = min(max(qc - 8, 0), 48); }
    float mx = -INFINITY;
    for (int k = t; k < nk; k += 256) { int tok; float bias = 0.f;
        if (isx && k < 128) { const int kr = rs + (k >> 4), kc = cs + (k & 15); tok = b * SEQ + kr * 64 + kc;
            bias = p.na_rpb[((size_t)(l * 8 + h) * 15 + (kr - r + 7)) * 31 + (kc - qc + 15)]; }
        else tok = TX + b * CTX + (isx ? k - 128 : k);
        kt[k] = tok; const bf16_t* kp = p.QKV + (size_t)tok * 3072 + 2048 + h * 64; float d = 0.f;
        for (int i = 0; i < 64; ++i) d += q[i] * bf2f(kp[i]);
        d = d * 0.125f + bias; s[k] = d; mx = fmaxf(mx, d); }
    mx = block_max256(mx, red);
    float ls = 0.f;
    for (int k = t; k < nk; k += 256) { float e = expf(s[k] - mx); s[k] = e; ls += e; }
    ls = block_sum256(ls, red);
    const int e = t & 63, part = t >> 6; float acc = 0.f;
    for (int k = part; k < nk; k += 4) acc += s[k] * bf2f(p.QKV[(size_t)kt[k] * 3072 + 2560 + h * 64 + e]);
    osum[part][e] = acc; __syncthreads();
    if (part == 0) p.O[(size_t)row * 1536 + 512 + h * 64 + e] = f2bf((osum[0][e] + osum[1][e] + osum[2][e] + osum[3][e]) / ls);
}

static inline size_t al256(size_t v) { return (v + 255) & ~(size_t)255; }
extern "C" void kernel_launch(void* const* d_in, const int* in_sizes, int n_in, void* d_out, int out_size, void* d_ws, size_t ws_size, hipStream_t stream) {
    P p{};
    p.x = (const float*)d_in[0]; p.c = (const float*)d_in[1]; p.ctx = (const float*)d_in[2]; p.c_ctx = (const float*)d_in[3]; p.w_mod = (const float*)d_in[4]; p.b_mod = (const float*)d_in[5];
    p.nmg = (const float*)d_in[6]; p.nfg = (const float*)d_in[7]; p.w_in = (const float*)d_in[8]; p.da_lambda = (const float*)d_in[9]; p.da_subln_g = (const float*)d_in[10]; p.na_rpb = (const float*)d_in[11];
    p.w_branch = (const float*)d_in[12]; p.w_out = (const float*)d_in[13]; p.w_router = (const float*)d_in[14]; p.b_router = (const float*)d_in[15]; p.w_gu = (const float*)d_in[16]; p.b_gu = (const float*)d_in[17];
    p.w_dn = (const float*)d_in[18]; p.b_dn = (const float*)d_in[19]; p.final_g = (const float*)d_in[20]; p.out = (float*)d_out;
    char* ws = (char*)d_ws; size_t off = 0;
    auto take = [&](size_t bytes) { char* r = ws + off; off = al256(off + bytes); return r; };
    int* ctl = (int*)take(65536);
    p.CNT = ctl;
    p.X = (float*)take((size_t)T * D * 4); p.MOD = (float*)take((size_t)DEPTH * 9 * NMOD * 4); p.LAM = (float*)take(256); p.ROPE = (float*)take((size_t)2 * SEQ * 32 * 4);
    p.H1 = (bf16_t*)take((size_t)T * D * 2); p.QKV = (bf16_t*)take((size_t)T * 3072 * 2); p.G = (bf16_t*)take((size_t)T * 3072 * 2); p.F = (float*)take((size_t)T * 512 * 4);
    p.FtX = (bf16_t*)take((size_t)NB * 512 * 4096 * 2); p.FtY = (bf16_t*)take((size_t)NB * 512 * 512 * 2); p.CSX = (bf16_t*)take((size_t)2048 * 4096 * 2); p.CSY = (bf16_t*)take((size_t)256 * 512 * 2);
    p.O = (bf16_t*)take((size_t)T * 1536 * 2); p.Mf = (float*)take((size_t)T * D * 4); p.Mg = (bf16_t*)take((size_t)T * D * 2);
    p.ROWIDX = (int*)take((size_t)T * 4 * 4); p.SROWW = (float*)take((size_t)NEXP * CAP * 4);
    p.H2S = (bf16_t*)take((size_t)NEXP * CAP * D * 2); p.YS = p.H2S; p.ACT = (bf16_t*)take((size_t)NEXP * CAP * D * 2);
    if (off > ws_size) { fprintf(stderr, "workspace too small: need %zu have %zu\n", off, ws_size); return; }
    hipMemsetAsync(ctl, 0, 65536, stream);
    k_mod<<<dim3(96, 4), 256, 0, stream>>>(p);
    k_lam<<<1, 256, 0, stream>>>(p);
    k_rope_tab<<<SEQ * 32 / 256, 256, 0, stream>>>(p);
    k_dft_tab<<<2048 * 4096 / 256, 256, 0, stream>>>(p);
    k_initx<<<T, 256, 0, stream>>>(p);
    for (int l = 0; l < DEPTH; ++l) {
        const bool last = l == DEPTH - 1; const int Tm = last ? TX : T;
        k_norm1<<<T / 4, 256, 0, stream>>>(p, l);
        nv_gemm<false, false, FInproj><<<dim3(INC / 64, T / 64, 1), 256, 0, stream>>>(FInproj{p, l, 0}, D);
        nv_rope<<<TX * 512 / 256, 256, 0, stream>>>(p);
        nv_chan_dft<<<T * 512 / 256, 256, 0, stream>>>(p);
        nv_diffattn<<<dim3(TX, 4), 256, 0, stream>>>(p, l, 0);
        nv_na<<<dim3(TX, 8), 256, 0, stream>>>(p, l, 0);
        nv_gemm<true, false, FFourX><<<dim3(512 / 64, SEQ / 64, NB), 256, 0, stream>>>(FFourX{p}, 4096);
        if (!last) {
            nv_diffattn<<<dim3(TY, 4), 256, 0, stream>>>(p, l, TX);
            nv_na<<<dim3(TY, 8), 256, 0, stream>>>(p, l, TX);
            nv_gemm<true, false, FFourY><<<dim3(512 / 64, CTX / 64, NB), 256, 0, stream>>>(FFourY{p}, 512);
        }
        for (int i = 0; i < 3; ++i) nv_gemm<false, false, FMerge><<<dim3(D / 64, Tm / 64, 1), 256, 0, stream>>>(FMerge{p, l, i, Tm, 0}, 512);
        nv_gemm<false, false, FOut><<<dim3(D / 64, Tm / 64, 1), 256, 0, stream>>>(FOut{p, l, Tm}, D);
        k_norm2_route<<<Tm / 4, 256, 0, stream>>>(p, l);
        nv_gemm<false, true, FGateUp><<<dim3(D / 64, CAP / 64, NEXP), 256, 0, stream>>>(FGateUp{p, l, 0}, D);
        nv_gemm<false, false, FDown><<<dim3(D / 64, CAP / 64, NEXP), 256, 0, stream>>>(FDown{p, l, 0}, D);
        k_combine<<<Tm / 4, 256, 0, stream>>>(p, l);
    }
    k_final<<<TX / 4, 256, 0, stream>>>(p);
}
```

```cpp
#include <hip/hip_runtime.h>
#include <hip/hip_bf16.h>
#include <stdint.h>
#include <stdio.h>
#define FAST_INPROJ 1
#define FAST_ATTN 1
#define FAST_FOUR 1
#define FAST_MERGE 1
#define FAST_OUT 1
#define FAST_MOE 1

typedef unsigned short bf16_t;
__device__ __forceinline__ float bf2f(bf16_t v) { return __uint_as_float(((unsigned)v) << 16); }
__device__ __forceinline__ bf16_t f2bf(float f) { unsigned u = __float_as_uint(f); u += 0x7FFFu + ((u >> 16) & 1u); return (bf16_t)(u >> 16); }

constexpr int D = 1024, NB = 8, SEQ = 2048, CTX = 256, TX = NB * SEQ, TY = NB * CTX, T = TX + TY, DEPTH = 4;
constexpr int NMOD = 6 * D, INC = 6656, NEXP = 32, CAP = T;
constexpr float EPS = 1e-6f;

struct P {
    const float *x, *c, *ctx, *c_ctx, *w_mod, *b_mod, *nmg, *nfg, *w_in, *da_lambda, *da_subln_g, *na_rpb, *w_branch, *w_out, *w_router, *b_router, *w_gu, *b_gu, *w_dn, *b_dn, *final_g;
    float* out;
    float *X, *MOD, *LAM, *F, *Mf, *ROPE, *SROWW;
    bf16_t *H1, *QKV, *G, *FtX, *FtY, *CSX, *CSY, *O, *Mg, *H2S, *ACT, *YS;
    bf16_t *WinT, *WbT, *WoT, *WguT, *WdT;
    int *CNT, *ROWIDX;
};

__device__ __forceinline__ float wave_sum(float v) { for (int o = 32; o; o >>= 1) v += __shfl_xor(v, o); return v; }
__device__ __forceinline__ float wave_max(float v) { for (int o = 32; o; o >>= 1) v = fmaxf(v, __shfl_xor(v, o)); return v; }
__device__ __forceinline__ int modidx(int row) { return row < TX ? row / SEQ : NB; }

__global__ __launch_bounds__(256) void k_mod(P p) {
    __shared__ float sc[9][1024];
    __shared__ float red[4][9][64];
    const int t = threadIdx.x, l = blockIdx.y, n = blockIdx.x * 64 + (t & 63), kg = t >> 6;
    for (int i = t; i < 9 * 1024; i += 256) { int r = i >> 10, k = i & 1023; float v = r < 8 ? p.c[r * 1024 + k] : p.c_ctx[k]; sc[r][k] = v / (1.f + expf(-v)); }
    __syncthreads();
    float acc[9];
#pragma unroll
    for (int r = 0; r < 9; ++r) acc[r] = 0.f;
    const float* w = p.w_mod + (size_t)l * 1024 * NMOD + n;
#pragma unroll 8
    for (int k = kg * 256; k < kg * 256 + 256; ++k) { float wv = w[(size_t)k * NMOD];
#pragma unroll
        for (int r = 0; r < 9; ++r) acc[r] += sc[r][k] * wv; }
#pragma unroll
    for (int r = 0; r < 9; ++r) red[kg][r][t & 63] = acc[r];
    __syncthreads();
    for (int i = t; i < 9 * 64; i += 256) { int r = i >> 6, c = i & 63; int nn = blockIdx.x * 64 + c;
        p.MOD[(size_t)(l * 9 + r) * NMOD + nn] = red[0][r][c] + red[1][r][c] + red[2][r][c] + red[3][r][c] + p.b_mod[l * NMOD + nn]; }
}
__global__ void k_lam(P p) {
    int l = threadIdx.x >> 6, lane = threadIdx.x & 63;
    const float* d = p.da_lambda + l * 256;
    float a = wave_sum(d[lane] * d[64 + lane]), b = wave_sum(d[128 + lane] * d[192 + lane]);
    if (lane == 0) p.LAM[l] = expf(a) - expf(b) + (0.8f - 0.6f * expf(-0.3f * (float)l));
}
__global__ void k_rope_tab(P p) {
    int idx = blockIdx.x * 256 + threadIdx.x; if (idx >= SEQ * 32) return;
    int s = idx >> 5, j = idx & 31, axis = j >> 4, i = j & 15;
    float pos = axis == 0 ? (float)(s / 64) : (float)(s % 64);
    float fr = powf(10000.f, -(float)i / 16.f); float a = pos * fr;
    p.ROPE[idx] = cosf(a); p.ROPE[SEQ * 32 + idx] = sinf(a);
}
__global__ void k_dft_tab(P p) {
    size_t idx = (size_t)blockIdx.x * 256 + threadIdx.x;
    if (idx < (size_t)2048 * 4096) { int r = (int)(idx >> 12), k = (int)(idx & 4095); int n = k & 2047; int m = (r * n) & 2047; float a = (float)m / 1024.f;
        p.CSX[idx] = f2bf(k < 2048 ? cospif(a) : -sinpif(a)); }
    if (idx < (size_t)256 * 512) { int r = (int)(idx >> 9), k = (int)(idx & 511); int n = k & 255; int m = (r * n) & 255; float a = (float)m / 128.f;
        p.CSY[idx] = f2bf(k < 256 ? cospif(a) : -sinpif(a)); }
}
__global__ void k_initx(P p) {
    size_t i = (size_t)blockIdx.x * 256 + threadIdx.x; if (i >= (size_t)T * 256) return;
    const size_t nx = (size_t)TX * 256;
    ((float4*)p.X)[i] = i < nx ? ((const float4*)p.x)[i] : ((const float4*)p.ctx)[i - nx];
}

__global__ __launch_bounds__(256) void k_norm1(P p, int l) {
    const int row = blockIdx.x * 4 + (threadIdx.x >> 6), lane = threadIdx.x & 63;
    const float4* xr = (const float4*)(p.X + (size_t)row * D);
    float4 v[4]; float ss = 0.f;
#pragma unroll
    for (int i = 0; i < 4; ++i) { v[i] = xr[lane + 64 * i]; ss += v[i].x * v[i].x + v[i].y * v[i].y + v[i].z * v[i].z + v[i].w * v[i].w; }
    ss = wave_sum(ss); const float rs = rsqrtf(ss * (1.f / D) + EPS);
    const float* md = p.MOD + (size_t)(l * 9 + modidx(row)) * NMOD; const float* g = p.nmg + l * D;
#pragma unroll
    for (int i = 0; i < 4; ++i) { const int c = (lane + 64 * i) * 4; const float4 gg = *(const float4*)(g + c), sh = *(const float4*)(md + c), sc = *(const float4*)(md + D + c);
        ushort4 o; o.x = f2bf(v[i].x * rs * gg.x * (1.f + sc.x) + sh.x); o.y = f2bf(v[i].y * rs * gg.y * (1.f + sc.y) + sh.y); o.z = f2bf(v[i].z * rs * gg.z * (1.f + sc.z) + sh.z); o.w = f2bf(v[i].w * rs * gg.w * (1.f + sc.w) + sh.w);
        *(ushort4*)(p.H1 + (size_t)row * D + c) = o; }
}
__global__ __launch_bounds__(256) void k_norm2_route(P p, int l) {
    __shared__ float hs[4][1024];
    const int w = threadIdx.x >> 6, row = blockIdx.x * 4 + w, lane = threadIdx.x & 63;
    const float4* xr = (const float4*)(p.X + (size_t)row * D);
    float4 v[4]; float ss = 0.f;
#pragma unroll
    for (int i = 0; i < 4; ++i) { v[i] = xr[lane + 64 * i]; ss += v[i].x * v[i].x + v[i].y * v[i].y + v[i].z * v[i].z + v[i].w * v[i].w; }
    ss = wave_sum(ss); const float rs = rsqrtf(ss * (1.f / D) + EPS);
    const float* md = p.MOD + (size_t)(l * 9 + modidx(row)) * NMOD; const float* g = p.nfg + l * D;
    ushort4 hb[4];
#pragma unroll
    for (int i = 0; i < 4; ++i) { const int c = (lane + 64 * i) * 4; const float4 gg = *(const float4*)(g + c), sh = *(const float4*)(md + 3 * D + c), sc = *(const float4*)(md + 4 * D + c);
        float4 h; h.x = v[i].x * rs * gg.x * (1.f + sc.x) + sh.x; h.y = v[i].y * rs * gg.y * (1.f + sc.y) + sh.y; h.z = v[i].z * rs * gg.z * (1.f + sc.z) + sh.z; h.w = v[i].w * rs * gg.w * (1.f + sc.w) + sh.w;
        *(float4*)(&hs[w][c]) = h; hb[i].x = f2bf(h.x); hb[i].y = f2bf(h.y); hb[i].z = f2bf(h.z); hb[i].w = f2bf(h.w); }
    __syncthreads();
    const int e = lane & 31, half = lane >> 5;
    const float* wr = p.w_router + (size_t)l * D * NEXP + e;
    float acc = 0.f;
#pragma unroll 8
    for (int k = half * 512; k < half * 512 + 512; ++k) acc += hs[w][k] * wr[(size_t)k * NEXP];
    acc += __shfl_xor(acc, 32);
    float logit = acc + p.b_router[l * NEXP + e];
    float tv[4]; int ti[4];
#pragma unroll
    for (int r = 0; r < 4; ++r) {
        float bv = logit; int bi = e;
        for (int o = 16; o; o >>= 1) { float ov = __shfl_xor(bv, o); int oi = __shfl_xor(bi, o); if (ov > bv || (ov == bv && oi < bi)) { bv = ov; bi = oi; } }
        tv[r] = bv; ti[r] = bi; if (e == bi) logit = -INFINITY;
    }
    float e1 = expf(tv[1] - tv[0]), e2 = expf(tv[2] - tv[0]), e3 = expf(tv[3] - tv[0]); float inv = 1.f / (1.f + e1 + e2 + e3);
    float wk[4] = {inv, e1 * inv, e2 * inv, e3 * inv};
    int myrow = 0;
    if (lane < 4) { int ee = ti[0]; float ww = wk[0];
        if (lane == 1) { ee = ti[1]; ww = wk[1]; } if (lane == 2) { ee = ti[2]; ww = wk[2]; } if (lane == 3) { ee = ti[3]; ww = wk[3]; }
        int pos = atomicAdd(&p.CNT[l * NEXP + ee], 1); myrow = ee * CAP + pos; p.ROWIDX[row * 4 + lane] = myrow; p.SROWW[myrow] = ww; }
#pragma unroll
    for (int k = 0; k < 4; ++k) { const int rr = __shfl(myrow, k); bf16_t* dst = p.H2S + (size_t)rr * D;
#pragma unroll
        for (int i = 0; i < 4; ++i) *(ushort4*)(dst + (lane + 64 * i) * 4) = hb[i]; }
}
__global__ __launch_bounds__(256) void k_combine(P p, int l) {
    const int row = blockIdx.x * 4 + (threadIdx.x >> 6), lane = threadIdx.x & 63;
    const float* md = p.MOD + (size_t)(l * 9 + modidx(row)) * NMOD + 5 * D;
    int ri[4];
#pragma unroll
    for (int k = 0; k < 4; ++k) ri[k] = p.ROWIDX[row * 4 + k];
#pragma unroll
    for (int i = 0; i < 4; ++i) { const int c = (lane + 64 * i) * 4; float4 s = {0.f, 0.f, 0.f, 0.f};
#pragma unroll
        for (int k = 0; k < 4; ++k) { const ushort4 y = *(const ushort4*)(p.YS + (size_t)ri[k] * D + c); s.x += bf2f(y.x); s.y += bf2f(y.y); s.z += bf2f(y.z); s.w += bf2f(y.w); }
        const float4 g2 = *(const float4*)(md + c); float4* xp = (float4*)(p.X + (size_t)row * D + c); float4 xv = *xp;
        xv.x += g2.x * s.x; xv.y += g2.y * s.y; xv.z += g2.z * s.z; xv.w += g2.w * s.w; *xp = xv; }
}
__global__ __launch_bounds__(256) void k_final(P p) {
    const int row = blockIdx.x * 4 + (threadIdx.x >> 6), lane = threadIdx.x & 63;
    const float4* xr = (const float4*)(p.X + (size_t)row * D);
    float4 v[4]; float ss = 0.f;
#pragma unroll
    for (int i = 0; i < 4; ++i) { v[i] = xr[lane + 64 * i]; ss += v[i].x * v[i].x + v[i].y * v[i].y + v[i].z * v[i].z + v[i].w * v[i].w; }
    ss = wave_sum(ss); const float rs = rsqrtf(ss * (1.f / D) + EPS);
#pragma unroll
    for (int i = 0; i < 4; ++i) { const int c = (lane + 64 * i) * 4; const float4 gg = *(const float4*)(p.final_g + c);
        float4 o; o.x = v[i].x * rs * gg.x; o.y = v[i].y * rs * gg.y; o.z = v[i].z * rs * gg.z; o.w = v[i].w * rs * gg.w;
        *(float4*)(p.out + (size_t)row * D + c) = o; }
}

template <bool BT, bool DUAL, class F>
__global__ __launch_bounds__(256) void nv_gemm(F f, int K) {
    __shared__ float As[16][68], Bs[16][68], Bs2[DUAL ? 16 : 1][68];
    const int z = blockIdx.z, M = f.M(z);
    const int m0 = blockIdx.y * 64, n0 = blockIdx.x * 64;
    if (m0 >= M) return;
    const int t = threadIdx.x, tx = t & 15, ty = t >> 4;
    float acc[4][4], acc2[4][4];
#pragma unroll
    for (int i = 0; i < 4; ++i)
#pragma unroll
        for (int j = 0; j < 4; ++j) { acc[i][j] = 0.f; acc2[i][j] = 0.f; }
    for (int k0 = 0; k0 < K; k0 += 16) {
        { const int r = t >> 2, kk = (t & 3) * 4, m = m0 + r;
#pragma unroll
          for (int i = 0; i < 4; ++i) As[kk + i][r] = (m < M) ? f.a(z, m, k0 + kk + i) : 0.f; }
        if (BT) { const int kk = t & 15, nn = (t >> 4) * 4;
#pragma unroll
          for (int i = 0; i < 4; ++i) { Bs[kk][nn + i] = f.b(z, k0 + kk, n0 + nn + i); if (DUAL) Bs2[kk][nn + i] = f.b2(z, k0 + kk, n0 + nn + i); } }
        else { const int kk = t >> 4, nn = (t & 15) * 4;
#pragma unroll
          for (int i = 0; i < 4; ++i) { Bs[kk][nn + i] = f.b(z, k0 + kk, n0 + nn + i); if (DUAL) Bs2[kk][nn + i] = f.b2(z, k0 + kk, n0 + nn + i); } }
        __syncthreads();
#pragma unroll
        for (int kk = 0; kk < 16; ++kk) { float a[4], b[4], b2[4];
#pragma unroll
            for (int i = 0; i < 4; ++i) { a[i] = As[kk][ty * 4 + i]; b[i] = Bs[kk][tx * 4 + i]; b2[i] = DUAL ? Bs2[kk][tx * 4 + i] : 0.f; }
#pragma unroll
            for (int i = 0; i < 4; ++i)
#pragma unroll
                for (int j = 0; j < 4; ++j) { acc[i][j] += a[i] * b[j]; if (DUAL) acc2[i][j] += a[i] * b2[j]; } }
        __syncthreads();
    }
#pragma unroll
    for (int i = 0; i < 4; ++i) { const int m = m0 + ty * 4 + i; if (m < M) {
#pragma unroll
        for (int j = 0; j < 4; ++j) f.out(z, m, n0 + tx * 4 + j, acc[i][j], acc2[i][j]); } }
}

struct FInproj { P p; int l, pad;
    __device__ int M(int) const { return T; }
    __device__ float a(int, int m, int k) const { return bf2f(p.H1[(size_t)m * D + k]); }
    __device__ float b(int, int k, int n) const { return p.w_in[((size_t)l * D + k) * INC + n]; }
    __device__ float b2(int, int, int) const { return 0.f; }
    __device__ void out(int, int m, int n, float v, float) const {
        if (n < 3072) p.QKV[(size_t)m * 3072 + n] = f2bf(v);
        else if (n < 3584) p.F[(size_t)m * 512 + (n - 3072)] = v;
        else p.G[(size_t)m * 3072 + (n - 3584)] = f2bf(1.f / (1.f + expf(-v)));
    } };
struct FFourX { P p;
    __device__ int M(int) const { return SEQ; }
    __device__ float a(int, int m, int k) const { return bf2f(p.CSX[(size_t)m * 4096 + k]); }
    __device__ float b(int z, int k, int n) const { return bf2f(p.FtX[((size_t)z * 512 + n) * 4096 + k]); }
    __device__ float b2(int, int, int) const { return 0.f; }
    __device__ void out(int z, int m, int n, float v, float) const { p.O[((size_t)z * SEQ + m) * 1536 + 1024 + n] = f2bf(v * (1.f / 512.f)); } };
struct FFourY { P p;
    __device__ int M(int) const { return CTX; }
    __device__ float a(int, int m, int k) const { return bf2f(p.CSY[(size_t)m * 512 + k]); }
    __device__ float b(int z, int k, int n) const { return bf2f(p.FtY[((size_t)z * 512 + n) * 512 + k]); }
    __device__ float b2(int, int, int) const { return 0.f; }
    __device__ void out(int z, int m, int n, float v, float) const { p.O[((size_t)TX + z * CTX + m) * 1536 + 1024 + n] = f2bf(v * 0.005524271728f); } };
struct FMerge { P p; int l, i, Mr, pad;
    __device__ int M(int) const { return Mr; }
    __device__ float a(int, int m, int k) const { return bf2f(p.O[(size_t)m * 1536 + i * 512 + k]); }
    __device__ float b(int, int k, int n) const { return p.w_branch[(((size_t)l * 3 + i) * 512 + k) * D + n]; }
    __device__ float b2(int, int, int) const { return 0.f; }
    __device__ void out(int, int m, int n, float v, float) const { const float g = bf2f(p.G[(size_t)m * 3072 + i * D + n]); float* mf = p.Mf + (size_t)m * D + n;
        if (i == 0) *mf = g * v; else if (i == 1) *mf += g * v; else p.Mg[(size_t)m * D + n] = f2bf(*mf + g * v); } };
struct FOut { P p; int l, Mr;
    __device__ int M(int) const { return Mr; }
    __device__ float a(int, int m, int k) const { return bf2f(p.Mg[(size_t)m * D + k]); }
    __device__ float b(int, int k, int n) const { return p.w_out[((size_t)l * D + k) * D + n]; }
    __device__ float b2(int, int, int) const { return 0.f; }
    __device__ void out(int, int m, int n, float v, float) const { p.X[(size_t)m * D + n] += p.MOD[(size_t)(l * 9 + modidx(m)) * NMOD + 2 * D + n] * v; } };
struct FGateUp { P p; int l, pad;
    __device__ int M(int z) const { return p.CNT[l * NEXP + z]; }
    __device__ float a(int z, int m, int k) const { return bf2f(p.H2S[((size_t)z * CAP + m) * D + k]); }
    __device__ float b(int z, int k, int n) const { return p.w_gu[(((size_t)l * NEXP + z) * D + k) * 2048 + n]; }
    __device__ float b2(int z, int k, int n) const { return p.w_gu[(((size_t)l * NEXP + z) * D + k) * 2048 + 1024 + n]; }
    __device__ void out(int z, int m, int n, float v, float v2) const { const float* bb = p.b_gu + ((size_t)l * NEXP + z) * 2048;
        float gate = fminf(v + bb[n], 7.f), up = fminf(fmaxf(v2 + bb[1024 + n], -7.f), 7.f);
        float act = gate / (1.f + expf(-1.702f * gate)) * (up + 1.f);
        p.ACT[((size_t)z * CAP + m) * D + n] = f2bf(act); } };
struct FDown { P p; int l, pad;
    __device__ int M(int z) const { return p.CNT[l * NEXP + z]; }
    __device__ float a(int z, int m, int k) const { return bf2f(p.ACT[((size_t)z * CAP + m) * D + k]); }
    __device__ float b(int z, int k, int n) const { return p.w_dn[(((size_t)l * NEXP + z) * D + k) * D + n]; }
    __device__ float b2(int, int, int) const { return 0.f; }
    __device__ void out(int z, int m, int n, float v, float) const { const size_t r = (size_t)z * CAP + m;
        p.YS[r * D + n] = f2bf((v + p.b_dn[((size_t)l * NEXP + z) * D + n]) * p.SROWW[r]); } };

__global__ __launch_bounds__(256) void nv_rope(P p) {
    size_t idx = (size_t)blockIdx.x * 256 + threadIdx.x; if (idx >= (size_t)TX * 512) return;
    const int row = (int)(idx >> 9), r = (int)(idx & 511);
    const int which = r >> 8, sub = (r >> 5) & 7, axis = (r >> 4) & 1, i = r & 15, s = row % SEQ;
    bf16_t* q = p.QKV + (size_t)row * 3072 + which * 512 + sub * 64 + axis * 32 + i;
    const float c = p.ROPE[s * 32 + axis * 16 + i], sn = p.ROPE[SEQ * 32 + s * 32 + axis * 16 + i];
    const float x1 = bf2f(q[0]), x2 = bf2f(q[16]);
    q[0] = f2bf(x1 * c - x2 * sn); q[16] = f2bf(x1 * sn + x2 * c);
}
__global__ __launch_bounds__(256) void nv_chan_dft(P p) {
    size_t idx = (size_t)blockIdx.x * 256 + threadIdx.x; if (idx >= (size_t)T * 512) return;
    const int row = (int)(idx >> 9), col = (int)(idx & 511), g = col >> 7, j = col & 127;
    const float* f = p.F + (size_t)row * 512 + g * 128; float uc = 0.f, us = 0.f;
    for (int c = 0; c < 128; ++c) { const float a = (float)((j * c) & 127) / 64.f; const float v = f[c]; uc += v * cospif(a); us += v * sinpif(a); }
    if (row < TX) { const int b = row / SEQ, n = row % SEQ; bf16_t* d = p.FtX + ((size_t)b * 512 + col) * 4096; d[n] = f2bf(uc); d[2048 + n] = f2bf(us); }
    else { const int b = (row - TX) / CTX, n = (row - TX) % CTX; bf16_t* d = p.FtY + ((size_t)b * 512 + col) * 512; d[n] = f2bf(uc); d[256 + n] = f2bf(us); }
}
__device__ __forceinline__ float block_max256(float v, float* red) { v = wave_max(v); __syncthreads(); if ((threadIdx.x & 63) == 0) red[threadIdx.x >> 6] = v; __syncthreads(); return fmaxf(fmaxf(red[0], red[1]), fmaxf(red[2], red[3])); }
__device__ __forceinline__ float block_sum256(float v, float* red) { v = wave_sum(v); __syncthreads(); if ((threadIdx.x & 63) == 0) red[threadIdx.x >> 6] = v; __syncthreads(); return (red[0] + red[1]) + (red[2] + red[3]); }

__global__ __launch_bounds__(256) void nv_diffattn(P p, int l, int row0) {
    __shared__ float q[128]; __shared__ float s[2][2304]; __shared__ float red[4]; __shared__ float osum[2][128];
    const int row = row0 + blockIdx.x, h = blockIdx.y, t = threadIdx.x;
    const bool isx = row < TX; const int b = isx ? row / SEQ : (row - TX) / CTX; const int nk = isx ? SEQ + CTX : CTX;
    if (t < 128) q[t] = bf2f(p.QKV[(size_t)row * 3072 + h * 128 + t]);
    __syncthreads();
    float mx0 = -INFINITY, mx1 = -INFINITY;
    for (int k = t; k < nk; k += 256) { const size_t kr = isx ? (k < SEQ ? (size_t)b * SEQ + k : (size_t)TX + b * CTX + (k - SEQ)) : (size_t)TX + b * CTX + k;
        const bf16_t* kp = p.QKV + kr * 3072 + 512 + h * 128; float d0 = 0.f, d1 = 0.f;
        for (int d = 0; d < 64; ++d) { d0 += q[d] * bf2f(kp[d]); d1 += q[64 + d] * bf2f(kp[64 + d]); }
        d0 *= 0.125f; d1 *= 0.125f; s[0][k] = d0; s[1][k] = d1; mx0 = fmaxf(mx0, d0); mx1 = fmaxf(mx1, d1); }
    mx0 = block_max256(mx0, red); mx1 = block_max256(mx1, red);
    float l0 = 0.f, l1 = 0.f;
    for (int k = t; k < nk; k += 256) { float e0 = expf(s[0][k] - mx0), e1 = expf(s[1][k] - mx1); s[0][k] = e0; s[1][k] = e1; l0 += e0; l1 += e1; }
    l0 = block_sum256(l0, red); l1 = block_sum256(l1, red);
    const float lam = p.LAM[l], i0 = 1.f / l0, i1 = lam / l1;
    for (int k = t; k < nk; k += 256) s[0][k] = s[0][k] * i0 - s[1][k] * i1;
    __syncthreads();
    const int e = t & 127, half = t >> 7; float acc = 0.f;
    for (int k = half; k < nk; k += 2) { const size_t kr = isx ? (k < SEQ ? (size_t)b * SEQ + k : (size_t)TX + b * CTX + (k - SEQ)) : (size_t)TX + b * CTX + k;
        acc += s[0][k] * bf2f(p.QKV[kr * 3072 + 1024 + h * 128 + e]); }
    osum[half][e] = acc; __syncthreads();
    float o = osum[0][e] + osum[1][e];
    float ss = block_sum256(half == 0 ? o * o : 0.f, red);
    const float li = 0.8f - 0.6f * expf(-0.3f * (float)l);
    if (half == 0) p.O[(size_t)row * 1536 + h * 128 + e] = f2bf(o * rsqrtf(ss * (1.f / 128.f) + EPS) * p.da_subln_g[l * 128 + e] * (1.f - li));
}
__global__ __launch_bounds__(256) void nv_na(P p, int l, int row0) {
    __shared__ float q[64]; __shared__ float s[384]; __shared__ int kt[384]; __shared__ float red[4]; __shared__ float osum[4][64];
    const int row = row0 + blockIdx.x, h = blockIdx.y, t = threadIdx.x;
    const bool isx = row < TX; const int b = isx ? row / SEQ : (row - TX) / CTX; const int nk = isx ? 384 : 256;
    if (t < 64) q[t] = bf2f(p.QKV[(size_t)row * 3072 + 1536 + h * 64 + t]);
    __syncthreads();
    int r = 0, qc = 0, rs = 0, cs = 0;
    if (isx) { const int sq = row % SEQ; r = sq / 64; qc = sq % 64; rs = min(max(r - 4, 0), 24); cs = min(max(qc - 8, 0), 48); }
    float mx = -INFINITY;
    for (int k = t; k < nk; k += 256) { int tok; float bias = 0.f;
        if (isx && k < 128) { const int kr = rs + (k >> 4), kc = cs + (k & 15); tok = b * SEQ + kr * 64 + kc;
            bias = p.na_rpb[((size_t)(l * 8 + h) * 15 + (kr - r + 7)) * 31 + (kc - qc + 15)]; }
        else tok = TX + b * CTX + (isx ? k - 128 : k);
        kt[k] = tok; const bf16_t* kp = p.QKV + (size_t)tok * 3072 + 2048 + h * 64; float d = 0.f;
        for (int i = 0; i < 64; ++i) d += q[i] * bf2f(kp[i]);
        d = d * 0.125f + bias; s[k] = d; mx = fmaxf(mx, d); }
    mx = block_max256(mx, red);
    float ls = 0.f;
    for (int k = t; k < nk; k += 256) { float e = expf(s[k] - mx); s[k] = e; ls += e; }
    ls = block_sum256(ls, red);
    const int e = t & 63, part = t >> 6; float acc = 0.f;
    for (int k = part; k < nk; k += 4) acc += s[k] * bf2f(p.QKV[(size_t)kt[k] * 3072 + 2560 + h * 64 + e]);
    osum[part][e] = acc; __syncthreads();
    if (part == 0) p.O[(size_t)row * 1536 + 512 + h * 64 + e] = f2bf((osum[0][e] + osum[1][e] + osum[2][e] + osum[3][e]) / ls);
}


#define LAS __attribute__((address_space(3)))
typedef short bf16x8 __attribute__((ext_vector_type(8)));
typedef float f32x4 __attribute__((ext_vector_type(4)));
typedef unsigned u32x4 __attribute__((ext_vector_type(4)));
constexpr int BM = 256, BK = 64, HALF = 128, HTB = HALF * BK * 2, STAGE_BYTES = 8 * HTB, NXCD = 8, WGM = 8;
constexpr int LDS_SCRATCH = STAGE_BYTES, LDS_TOTAL = STAGE_BYTES + 16384;
__device__ __forceinline__ int lds_byte(int r, int c) { const int st = (r >> 4) * 2 + (c >> 5), rr = r & 15, cc = c & 31, ob = rr * 64 + cc * 2; return st * 1024 + (ob ^ (((ob >> 9) & 1) << 5)); }
__device__ __forceinline__ void stage_rc(int b, int& R, int& C) { const int st = b / 1024, sb = b % 1024, swz = sb ^ (((sb >> 9) & 1) << 5); R = (st >> 1) * 16 + swz / 64; C = (st & 1) * 32 + (swz % 64) / 2; }
__device__ __forceinline__ int perm32(int rho) { const int n = rho >> 4, i = rho & 15; return 8 * (i >> 2) + 4 * n + (i & 3); }
__device__ __forceinline__ unsigned cvt_pk_bf16(float lo, float hi) { unsigned r; asm volatile("v_cvt_pk_bf16_f32 %0, %1, %2" : "=v"(r) : "v"(lo), "v"(hi)); return r; }
__device__ __forceinline__ float sigmoidf_(float v) { return 1.f / (1.f + __expf(-v)); }

struct GUnit { const char *a0, *a1, *b0, *b1; int pm, pn, e, pad; };
__device__ __forceinline__ bool static_tile(int L, int nM, int nN, int& pm, int& pn) {
    const int nwg = nM * nN; if (L >= nwg) return false;
    int wgid = L; { const int q = nwg / NXCD, r = nwg % NXCD, xcd = wgid % NXCD, off = wgid / NXCD; wgid = (xcd < r ? xcd * (q + 1) : r * (q + 1) + (xcd - r) * q) + off; }
    const int nig = WGM * nN, gid = wgid / nig, fm = gid * WGM, gsz = (nM - fm) < WGM ? (nM - fm) : WGM;
    pm = fm + ((wgid % nig) % gsz); pn = (wgid % nig) / gsz; return true;
}

template <class G>
__device__ __forceinline__ void gemm_phase(LAS unsigned char* lds, const G& g) {
    const int tid = threadIdx.x, wid = __builtin_amdgcn_readfirstlane(tid >> 6), lane = tid & 63, wr = wid >> 2, wc = wid & 3, fr = lane & 15, fq = lane >> 4;
    const int nt = g.K / BK;
    unsigned voffA[2], voffB[2];
#pragma unroll
    for (int i = 0; i < 2; ++i) { int R, C; stage_rc(tid * 16 + i * 8192, R, C); const int Rb = G::PERM ? ((R & ~31) + perm32(R & 31)) : R;
        voffA[i] = (unsigned)(R * g.lda + C) * 2u; voffB[i] = (unsigned)(Rb * g.ldb + C) * 2u; }
    const size_t kstep = (size_t)(BK * 2);
    const unsigned ldsw = (unsigned)wid * 1024u;
    const int aoff = lds_byte(wr * 64 + fr, fq * 8), boff = lds_byte(wc * 32 + fr, fq * 8);
#define PG8_SA(b, h) (((b) * 2 + (h)) * HTB)
#define PG8_SB(b, h) ((4 + (b) * 2 + (h)) * HTB)
#define PG8_STAGE(bufoff, gbase, voff) do { _Pragma("unroll") for (int _i = 0; _i < 2; ++_i) \
        __builtin_amdgcn_global_load_lds((const unsigned*)((const char*)(gbase) + (voff)[_i]), (LAS unsigned*)(lds + (bufoff) + ldsw + _i * 8192), 16, 0, 0); } while (0)
#define PG8_LDA(dst, b, h) do { _Pragma("unroll") for (int m = 0; m < 4; ++m) _Pragma("unroll") for (int k = 0; k < 2; ++k) dst[m][k] = *(const LAS bf16x8*)(lds + PG8_SA(b, h) + aoff + m * 2048 + k * 1024); } while (0)
#define PG8_LDB(dst, b, h) do { _Pragma("unroll") for (int n = 0; n < 2; ++n) _Pragma("unroll") for (int k = 0; k < 2; ++k) dst[n][k] = *(const LAS bf16x8*)(lds + PG8_SB(b, h) + boff + n * 2048 + k * 1024); } while (0)
#define PG8_MMA(ai, bj, At, Bt) do { __builtin_amdgcn_s_setprio(1); _Pragma("unroll") for (int m = 0; m < 4; ++m) _Pragma("unroll") for (int n = 0; n < 2; ++n) _Pragma("unroll") for (int k = 0; k < 2; ++k) \
        acc[ai][bj][m][n] = __builtin_amdgcn_mfma_f32_16x16x32_bf16(Bt[n][k], At[m][k], acc[ai][bj][m][n], 0, 0, 0); __builtin_amdgcn_s_setprio(0); } while (0)
#define PG8_WAIT_V(n) asm volatile("s_waitcnt vmcnt(" #n ")" ::: "memory")
#define PG8_WAIT_L(n) asm volatile("s_waitcnt lgkmcnt(" #n ")" ::: "memory")
#define PG8_BAR __builtin_amdgcn_s_barrier()
#define PG8_SCHED __builtin_amdgcn_sched_barrier(0)
    GUnit cur, nxt; int ui = 0;
    if (!g.next(0, cur)) return;
    f32x4 acc[2][2][4][2];
#pragma unroll
    for (int a = 0; a < 2; ++a)
#pragma unroll
        for (int b = 0; b < 2; ++b)
#pragma unroll
            for (int m = 0; m < 4; ++m)
#pragma unroll
                for (int n = 0; n < 2; ++n) acc[a][b][m][n] = (f32x4){0.f, 0.f, 0.f, 0.f};
    bf16x8 At[4][2], B0[2][2], B1[2][2];
    PG8_STAGE(PG8_SB(0, 0), cur.b0, voffB); PG8_STAGE(PG8_SA(0, 0), cur.a0, voffA); PG8_STAGE(PG8_SB(0, 1), cur.b1, voffB); PG8_STAGE(PG8_SA(0, 1), cur.a1, voffA);
    if (wr == 1) PG8_BAR;
    PG8_WAIT_V(4); PG8_BAR;
    PG8_STAGE(PG8_SB(1, 0), cur.b0 + kstep, voffB); PG8_STAGE(PG8_SA(1, 0), cur.a0 + kstep, voffA); PG8_STAGE(PG8_SB(1, 1), cur.b1 + kstep, voffB);
    PG8_WAIT_V(6); PG8_BAR;
    for (;;) {
        const bool has_next = g.next(ui + 1, nxt);
        if (!has_next) nxt = cur;
        for (int t = 0; t < nt; t += 2) {
            const bool last = (t == nt - 2);
            const char* a1h1 = cur.a1 + (size_t)(t + 1) * kstep;
            const char* a2_0 = last ? nxt.a0 : cur.a0 + (size_t)(t + 2) * kstep; const char* a2_1 = last ? nxt.a1 : cur.a1 + (size_t)(t + 2) * kstep;
            const char* b2_0 = last ? nxt.b0 : cur.b0 + (size_t)(t + 2) * kstep; const char* b2_1 = last ? nxt.b1 : cur.b1 + (size_t)(t + 2) * kstep;
            PG8_LDB(B0, 0, 0); PG8_SCHED; PG8_LDA(At, 0, 0); PG8_STAGE(PG8_SA(1, 1), a1h1, voffA);
            PG8_WAIT_L(8); PG8_BAR; PG8_WAIT_L(0); PG8_MMA(0, 0, At, B0); PG8_BAR; PG8_SCHED;
            PG8_LDB(B1, 0, 1); PG8_STAGE(PG8_SB(0, 0), b2_0, voffB);
            PG8_BAR; PG8_WAIT_L(0); PG8_MMA(0, 1, At, B1); PG8_BAR;
            PG8_LDA(At, 0, 1); PG8_STAGE(PG8_SA(0, 0), a2_0, voffA);
            PG8_BAR; PG8_WAIT_L(0); PG8_MMA(1, 0, At, B0); PG8_BAR; PG8_SCHED;
            PG8_STAGE(PG8_SB(0, 1), b2_1, voffB);
            PG8_WAIT_V(6); PG8_BAR; PG8_MMA(1, 1, At, B1); PG8_BAR;
            PG8_LDB(B0, 1, 0); PG8_SCHED; PG8_LDA(At, 1, 0); PG8_STAGE(PG8_SA(0, 1), a2_1, voffA);
            PG8_WAIT_L(8); PG8_BAR; PG8_WAIT_L(0); PG8_MMA(0, 0, At, B0); PG8_BAR; PG8_SCHED;
            PG8_LDB(B1, 1, 1); PG8_STAGE(PG8_SB(1, 0), b2_0 + kstep, voffB);
            PG8_BAR; PG8_WAIT_L(0); PG8_MMA(0, 1, At, B1); PG8_BAR;
            PG8_LDA(At, 1, 1); PG8_STAGE(PG8_SA(1, 0), a2_0 + kstep, voffA);
            PG8_BAR; PG8_WAIT_L(0); PG8_MMA(1, 0, At, B0); PG8_BAR; PG8_SCHED;
            PG8_STAGE(PG8_SB(1, 1), b2_1 + kstep, voffB);
            PG8_WAIT_V(6); PG8_BAR; PG8_MMA(1, 1, At, B1); PG8_BAR;
        }
        g.epi(acc, cur, wr, wc, fr, fq);
        if (!has_next) break;
#pragma unroll
        for (int a = 0; a < 2; ++a)
#pragma unroll
            for (int b = 0; b < 2; ++b)
#pragma unroll
                for (int m = 0; m < 4; ++m)
#pragma unroll
                    for (int n = 0; n < 2; ++n) acc[a][b][m][n] = (f32x4){0.f, 0.f, 0.f, 0.f};
        cur = nxt; ++ui;
    }
    PG8_WAIT_V(0);
    if (wr == 0) PG8_BAR;
    PG8_BAR;
#undef PG8_SA
#undef PG8_SB
#undef PG8_STAGE
#undef PG8_LDA
#undef PG8_LDB
#undef PG8_MMA
#undef PG8_WAIT_V
#undef PG8_WAIT_L
#undef PG8_BAR
#undef PG8_SCHED
}

__global__ __launch_bounds__(256) void k_tcvt(const float* src, bf16_t* dst, int ldsrc, int Kdim, size_t src_bstride, size_t dst_bstride) {
    __shared__ float tl[64][65];
    const float* s = src + (size_t)blockIdx.z * src_bstride; bf16_t* d = dst + (size_t)blockIdx.z * dst_bstride;
    const int k0 = blockIdx.y * 64, n0 = blockIdx.x * 64, t = threadIdx.x;
    for (int i = t; i < 4096; i += 256) { const int kk = i >> 6, nn = i & 63; tl[kk][nn] = s[(size_t)(k0 + kk) * ldsrc + n0 + nn]; }
    __syncthreads();
    for (int i = t; i < 4096; i += 256) { const int nn = i >> 6, kk = i & 63; d[(size_t)(n0 + nn) * Kdim + k0 + kk] = f2bf(tl[kk][nn]); }
}
__global__ __launch_bounds__(256) void k_wucus(P p) {
    const int l = blockIdx.y; const int idx = blockIdx.x * 256 + threadIdx.x; const int k = idx & 1023, col = idx >> 10, g = col >> 7, j = col & 127;
    const float* w = p.w_in + ((size_t)l * D + k) * INC + 3072 + g * 128; float uc = 0.f, us = 0.f;
    for (int c = 0; c < 128; ++c) { const float a = (float)((j * c) & 127) / 64.f; const float v = w[c]; uc += v * cospif(a); us += v * sinpif(a); }
    bf16_t* wt = p.WinT + (size_t)l * 7168 * D;
    wt[(size_t)(3072 + col) * D + k] = f2bf(uc); wt[(size_t)(3584 + col) * D + k] = f2bf(us);
}

struct GInproj {
    static constexpr bool PERM = true;
    P p; int l, lda, ldb, K, G, c;
    __device__ __forceinline__ bool next(int i, GUnit& u) const {
        int pm, pn; if (!static_tile(i * G + c, T / 256, 28, pm, pn)) return false;
        u.pm = pm; u.pn = pn; u.e = 0; u.pad = 0;
        u.a0 = (const char*)(p.H1 + (size_t)pm * 256 * D); u.a1 = u.a0 + (size_t)HALF * D * 2;
        u.b0 = (const char*)(p.WinT + ((size_t)l * 7168 + pn * 256) * D); u.b1 = u.b0 + (size_t)HALF * D * 2; return true; }
    __device__ __forceinline__ void epi(const f32x4 (&acc)[2][2][4][2], const GUnit& u, int wr, int wc, int fr, int fq) const {
        const int row0 = u.pm * 256 + wr * 64 + fr, pn = u.pn;
        if (pn < 12) {
            const bool rope = (pn < 4) && (u.pm < TX / 256);
#pragma unroll
            for (int ai = 0; ai < 2; ++ai)
#pragma unroll
                for (int m = 0; m < 4; ++m) { const int row = row0 + ai * HALF + m * 16;
#pragma unroll
                    for (int bj = 0; bj < 2; ++bj) { f32x4 v0 = acc[ai][bj][m][0], v1 = acc[ai][bj][m][1]; const int col0 = pn * 256 + bj * HALF + wc * 32 + 8 * fq;
                        if (rope) { const int s = row & (SEQ - 1), axis = wc & 1, i0 = 8 * (fq & 1); const float sg = (fq >> 1) ? 1.f : -1.f;
                            const float* ct = p.ROPE + s * 32 + axis * 16 + i0; const float* st = ct + SEQ * 32;
                            const f32x4 c0 = *(const f32x4*)ct, c1 = *(const f32x4*)(ct + 4), s0 = *(const f32x4*)st, s1 = *(const f32x4*)(st + 4);
                            f32x4 q0, q1;
#pragma unroll
                            for (int j = 0; j < 4; ++j) { q0[j] = __shfl_xor(v0[j], 32); q1[j] = __shfl_xor(v1[j], 32); }
                            v0 = v0 * c0 + sg * (q0 * s0); v1 = v1 * c1 + sg * (q1 * s1); }
                        u32x4 w; w.x = cvt_pk_bf16(v0[0], v0[1]); w.y = cvt_pk_bf16(v0[2], v0[3]); w.z = cvt_pk_bf16(v1[0], v1[1]); w.w = cvt_pk_bf16(v1[2], v1[3]);
                        *(u32x4*)(p.QKV + (size_t)row * 3072 + col0) = w; } }
        } else if (pn < 16) {
#pragma unroll
            for (int ai = 0; ai < 2; ++ai)
#pragma unroll
                for (int m = 0; m < 4; ++m) { const int row = row0 + ai * HALF + m * 16;
                    bf16_t* base; size_t cstride; int soff;
                    if (row < TX) { const int b = row >> 11, n = row & (SEQ - 1); base = p.FtX + (size_t)b * 512 * 4096 + n; cstride = 4096; soff = 2048; }
                    else { const int b = (row - TX) >> 8, n = (row - TX) & (CTX - 1); base = p.FtY + (size_t)b * 512 * 512 + n; cstride = 512; soff = 256; }
#pragma unroll
                    for (int bj = 0; bj < 2; ++bj) { const int col0 = (pn - 12) * 256 + bj * HALF + wc * 32 + 8 * fq; bf16_t* d = base + (size_t)(col0 & 511) * cstride + (col0 >= 512 ? soff : 0);
#pragma unroll
                        for (int n = 0; n < 2; ++n)
#pragma unroll
                            for (int j = 0; j < 4; ++j) d[(size_t)(4 * n + j) * cstride] = f2bf(acc[ai][bj][m][n][j]); } }
        } else {
#pragma unroll
            for (int ai = 0; ai < 2; ++ai)
#pragma unroll
                for (int m = 0; m < 4; ++m) { const int row = row0 + ai * HALF + m * 16;
#pragma unroll
                    for (int bj = 0; bj < 2; ++bj) { const f32x4 v0 = acc[ai][bj][m][0], v1 = acc[ai][bj][m][1]; const int col0 = (pn - 16) * 256 + bj * HALF + wc * 32 + 8 * fq;
                        u32x4 w; w.x = cvt_pk_bf16(sigmoidf_(v0[0]), sigmoidf_(v0[1])); w.y = cvt_pk_bf16(sigmoidf_(v0[2]), sigmoidf_(v0[3])); w.z = cvt_pk_bf16(sigmoidf_(v1[0]), sigmoidf_(v1[1])); w.w = cvt_pk_bf16(sigmoidf_(v1[2]), sigmoidf_(v1[3]));
                        *(u32x4*)(p.G + (size_t)row * 3072 + col0) = w; } }
        }
    }
};
extern __shared__ __attribute__((aligned(16))) unsigned char dyn_smem[];
__global__ __launch_bounds__(512, 2) void k_inproj(P p, int l) {
    GInproj g{p, l, D, D, D, (int)gridDim.x, (int)blockIdx.x};
    gemm_phase(( LAS unsigned char*)dyn_smem, g);
}


struct GFourX {
    static constexpr bool PERM = true;
    P p; int lda, ldb, K, G, c, pad;
    __device__ __forceinline__ bool next(int i, GUnit& u) const {
        const int L = i * G + c; if (L >= 128) return false;
        const int b = L >> 4, pm = (L >> 1) & 7, pn = L & 1; u.pm = pm; u.pn = pn; u.e = b; u.pad = 0;
        u.a0 = (const char*)(p.CSX + (size_t)pm * 256 * 4096); u.a1 = u.a0 + (size_t)HALF * 4096 * 2;
        u.b0 = (const char*)(p.FtX + ((size_t)b * 512 + pn * 256) * 4096); u.b1 = u.b0 + (size_t)HALF * 4096 * 2; return true; }
    __device__ __forceinline__ void epi(const f32x4 (&acc)[2][2][4][2], const GUnit& u, int wr, int wc, int fr, int fq) const {
        const int row0 = u.e * SEQ + u.pm * 256 + wr * 64 + fr;
#pragma unroll
        for (int ai = 0; ai < 2; ++ai)
#pragma unroll
            for (int m = 0; m < 4; ++m) { const int row = row0 + ai * HALF + m * 16;
#pragma unroll
                for (int bj = 0; bj < 2; ++bj) { const f32x4 v0 = acc[ai][bj][m][0] * (1.f / 512.f), v1 = acc[ai][bj][m][1] * (1.f / 512.f); const int col0 = 1024 + u.pn * 256 + bj * HALF + wc * 32 + 8 * fq;
                    u32x4 w; w.x = cvt_pk_bf16(v0[0], v0[1]); w.y = cvt_pk_bf16(v0[2], v0[3]); w.z = cvt_pk_bf16(v1[0], v1[1]); w.w = cvt_pk_bf16(v1[2], v1[3]);
                    *(u32x4*)(p.O + (size_t)row * 1536 + col0) = w; } }
    }
};
struct GFourY {
    static constexpr bool PERM = true;
    P p; int lda, ldb, K, G, c, pad;
    __device__ __forceinline__ bool next(int i, GUnit& u) const {
        const int L = i * G + c; if (L >= 16) return false;
        const int b = L >> 1, pn = L & 1; u.pm = 0; u.pn = pn; u.e = b; u.pad = 0;
        u.a0 = (const char*)p.CSY; u.a1 = u.a0 + (size_t)HALF * 512 * 2;
        u.b0 = (const char*)(p.FtY + ((size_t)b * 512 + pn * 256) * 512); u.b1 = u.b0 + (size_t)HALF * 512 * 2; return true; }
    __device__ __forceinline__ void epi(const f32x4 (&acc)[2][2][4][2], const GUnit& u, int wr, int wc, int fr, int fq) const {
        const int row0 = TX + u.e * CTX + wr * 64 + fr;
#pragma unroll
        for (int ai = 0; ai < 2; ++ai)
#pragma unroll
            for (int m = 0; m < 4; ++m) { const int row = row0 + ai * HALF + m * 16;
#pragma unroll
                for (int bj = 0; bj < 2; ++bj) { const f32x4 v0 = acc[ai][bj][m][0] * 0.005524271728f, v1 = acc[ai][bj][m][1] * 0.005524271728f; const int col0 = 1024 + u.pn * 256 + bj * HALF + wc * 32 + 8 * fq;
                    u32x4 w; w.x = cvt_pk_bf16(v0[0], v0[1]); w.y = cvt_pk_bf16(v0[2], v0[3]); w.z = cvt_pk_bf16(v1[0], v1[1]); w.w = cvt_pk_bf16(v1[2], v1[3]);
                    *(u32x4*)(p.O + (size_t)row * 1536 + col0) = w; } }
    }
};
struct GMerge {
    static constexpr bool PERM = true;
    P p; int l, nM, lda, ldb, K, G, c, pad;
    __device__ __forceinline__ bool next(int i, GUnit& u) const {
        const int ti = i / 3, br = i - ti * 3; int pm, pn; if (!static_tile(ti * G + c, nM, 4, pm, pn)) return false;
        u.pm = pm; u.pn = pn; u.e = br; u.pad = 0;
        u.a0 = (const char*)(p.O + (size_t)pm * 256 * 1536 + br * 512); u.a1 = u.a0 + (size_t)HALF * 1536 * 2;
        u.b0 = (const char*)(p.WbT + (((size_t)l * 3 + br) * D + pn * 256) * 512); u.b1 = u.b0 + (size_t)HALF * 512 * 2; return true; }
    __device__ __forceinline__ void epi(const f32x4 (&acc)[2][2][4][2], const GUnit& u, int wr, int wc, int fr, int fq) const {
        const int row0 = u.pm * 256 + wr * 64 + fr, br = u.e;
#pragma unroll
        for (int ai = 0; ai < 2; ++ai)
#pragma unroll
            for (int m = 0; m < 4; ++m) { const int row = row0 + ai * HALF + m * 16;
#pragma unroll
                for (int bj = 0; bj < 2; ++bj) { const int col0 = u.pn * 256 + bj * HALF + wc * 32 + 8 * fq;
                    const u32x4 gw = *(const u32x4*)(p.G + (size_t)row * 3072 + br * D + col0);
                    f32x4 g0, g1; g0[0] = __uint_as_float(gw.x << 16); g0[1] = __uint_as_float(gw.x & 0xffff0000u); g0[2] = __uint_as_float(gw.y << 16); g0[3] = __uint_as_float(gw.y & 0xffff0000u);
                    g1[0] = __uint_as_float(gw.z << 16); g1[1] = __uint_as_float(gw.z & 0xffff0000u); g1[2] = __uint_as_float(gw.w << 16); g1[3] = __uint_as_float(gw.w & 0xffff0000u);
                    f32x4 v0 = acc[ai][bj][m][0] * g0, v1 = acc[ai][bj][m][1] * g1;
                    float* mf = p.Mf + (size_t)row * D + col0;
                    if (br > 0) { v0 += *(const f32x4*)mf; v1 += *(const f32x4*)(mf + 4); }
                    if (br < 2) { *(f32x4*)mf = v0; *(f32x4*)(mf + 4) = v1; }
                    else { u32x4 w; w.x = cvt_pk_bf16(v0[0], v0[1]); w.y = cvt_pk_bf16(v0[2], v0[3]); w.z = cvt_pk_bf16(v1[0], v1[1]); w.w = cvt_pk_bf16(v1[2], v1[3]);
                        *(u32x4*)(p.Mg + (size_t)row * D + col0) = w; } } }
    }
};
struct GOut {
    static constexpr bool PERM = false;
    P p; int l, nM, lda, ldb, K, G, c, pad;
    __device__ __forceinline__ bool next(int i, GUnit& u) const {
        int pm, pn; if (!static_tile(i * G + c, nM, 4, pm, pn)) return false;
        u.pm = pm; u.pn = pn; u.e = 0; u.pad = 0;
        u.a0 = (const char*)(p.Mg + (size_t)pm * 256 * D); u.a1 = u.a0 + (size_t)HALF * D * 2;
        u.b0 = (const char*)(p.WoT + ((size_t)l * D + pn * 256) * D); u.b1 = u.b0 + (size_t)HALF * D * 2; return true; }
    __device__ __forceinline__ void epi(const f32x4 (&acc)[2][2][4][2], const GUnit& u, int wr, int wc, int fr, int fq) const {
        const int row0 = u.pm * 256 + wr * 64 + fr, col0 = u.pn * 256 + wc * 32 + 4 * fq;
        const float* g1 = p.MOD + (size_t)(l * 9 + modidx(u.pm * 256)) * NMOD + 2 * D;
        f32x4 gv[2][2];
#pragma unroll
        for (int bj = 0; bj < 2; ++bj)
#pragma unroll
            for (int n = 0; n < 2; ++n) gv[bj][n] = *(const f32x4*)(g1 + col0 + bj * HALF + n * 16);
#pragma unroll
        for (int ai = 0; ai < 2; ++ai)
#pragma unroll
            for (int m = 0; m < 4; ++m) { float* rowp = p.X + (size_t)(row0 + ai * HALF + m * 16) * D + col0;
#pragma unroll
                for (int bj = 0; bj < 2; ++bj)
#pragma unroll
                    for (int n = 0; n < 2; ++n) { f32x4* xp = (f32x4*)(rowp + bj * HALF + n * 16); *xp = *xp + gv[bj][n] * acc[ai][bj][m][n]; } }
    }
};
__device__ __forceinline__ void moe_tiles(const P& p, int l, LAS int* mtb) {
    if (threadIdx.x < 64) { const int t = threadIdx.x; int v = t < NEXP ? (p.CNT[l * NEXP + t] + 255) >> 8 : 0;
        for (int o = 1; o < 32; o <<= 1) { const int u = __shfl_up(v, o); if ((t & 63) >= o) v += u; }
        if (t < NEXP) mtb[t + 1] = v; if (t == 0) mtb[0] = 0; }
    __syncthreads();
}
template <int NN>
__device__ __forceinline__ bool moe_unit(const LAS int* mtb, int i, int G, int c, int& e, int& rowbase, int& pn) {
    const int total = mtb[NEXP] * NN, per = (total + 7) >> 3, xcd = c & 7, r = c >> 3, Gx = G >> 3;
    const int L = xcd * per + i * Gx + r; const int lim = min((xcd + 1) * per, total); if (L >= lim) return false;
    const int mt = L / NN; pn = L - mt * NN; int ee = 0; while (ee < NEXP - 1 && mtb[ee + 1] <= mt) ++ee;
    e = ee; rowbase = ee * CAP + (mt - mtb[ee]) * 256; return true;
}
struct GGateUp {
    static constexpr bool PERM = true;
    P p; const LAS int* mtb; int l, lda, ldb, K, G, c;
    __device__ __forceinline__ bool next(int i, GUnit& u) const {
        int e, rb, pn; if (!moe_unit<8>(mtb, i, G, c, e, rb, pn)) return false;
        u.pm = rb; u.pn = pn; u.e = e; u.pad = 0;
        u.a0 = (const char*)(p.H2S + (size_t)rb * D); u.a1 = u.a0 + (size_t)HALF * D * 2;
        const bf16_t* w = p.WguT + ((size_t)l * NEXP + e) * 2048 * D; u.b0 = (const char*)(w + (size_t)pn * 128 * D); u.b1 = (const char*)(w + (size_t)(1024 + pn * 128) * D); return true; }
    __device__ __forceinline__ void epi(const f32x4 (&acc)[2][2][4][2], const GUnit& u, int wr, int wc, int fr, int fq) const {
        const int row0 = u.pm + wr * 64 + fr, j0 = u.pn * 128 + wc * 32 + 8 * fq;
        const float* bb = p.b_gu + ((size_t)l * NEXP + u.e) * 2048 + j0;
        f32x4 bg[2], bu[2];
#pragma unroll
        for (int n = 0; n < 2; ++n) { bg[n] = *(const f32x4*)(bb + 4 * n); bu[n] = *(const f32x4*)(bb + 1024 + 4 * n); }
#pragma unroll
        for (int ai = 0; ai < 2; ++ai)
#pragma unroll
            for (int m = 0; m < 4; ++m) { const int row = row0 + ai * HALF + m * 16; float a[8];
#pragma unroll
                for (int n = 0; n < 2; ++n)
#pragma unroll
                    for (int j = 0; j < 4; ++j) { const float gate = fminf(acc[ai][0][m][n][j] + bg[n][j], 7.f), up = fminf(fmaxf(acc[ai][1][m][n][j] + bu[n][j], -7.f), 7.f);
                        a[4 * n + j] = gate * sigmoidf_(1.702f * gate) * (up + 1.f); }
                u32x4 w; w.x = cvt_pk_bf16(a[0], a[1]); w.y = cvt_pk_bf16(a[2], a[3]); w.z = cvt_pk_bf16(a[4], a[5]); w.w = cvt_pk_bf16(a[6], a[7]);
                *(u32x4*)(p.ACT + (size_t)row * D + j0) = w; }
    }
};
struct GDown {
    static constexpr bool PERM = true;
    P p; const LAS int* mtb; int l, lda, ldb, K, G, c;
    __device__ __forceinline__ bool next(int i, GUnit& u) const {
        int e, rb, pn; if (!moe_unit<4>(mtb, i, G, c, e, rb, pn)) return false;
        u.pm = rb; u.pn = pn; u.e = e; u.pad = 0;
        u.a0 = (const char*)(p.ACT + (size_t)rb * D); u.a1 = u.a0 + (size_t)HALF * D * 2;
        u.b0 = (const char*)(p.WdT + (((size_t)l * NEXP + e) * D + pn * 256) * D); u.b1 = u.b0 + (size_t)HALF * D * 2; return true; }
    __device__ __forceinline__ void epi(const f32x4 (&acc)[2][2][4][2], const GUnit& u, int wr, int wc, int fr, int fq) const {
        const int row0 = u.pm + wr * 64 + fr, colb = u.pn * 256 + wc * 32 + 8 * fq;
        const float* bb = p.b_dn + ((size_t)l * NEXP + u.e) * D + colb;
        f32x4 bv[2][2];
#pragma unroll
        for (int bj = 0; bj < 2; ++bj)
#pragma unroll
            for (int n = 0; n < 2; ++n) bv[bj][n] = *(const f32x4*)(bb + bj * HALF + 4 * n);
#pragma unroll
        for (int ai = 0; ai < 2; ++ai)
#pragma unroll
            for (int m = 0; m < 4; ++m) { const int row = row0 + ai * HALF + m * 16; const float rw = p.SROWW[row];
#pragma unroll
                for (int bj = 0; bj < 2; ++bj) { const f32x4 v0 = (acc[ai][bj][m][0] + bv[bj][0]) * rw, v1 = (acc[ai][bj][m][1] + bv[bj][1]) * rw;
                    u32x4 w; w.x = cvt_pk_bf16(v0[0], v0[1]); w.y = cvt_pk_bf16(v0[2], v0[3]); w.z = cvt_pk_bf16(v1[0], v1[1]); w.w = cvt_pk_bf16(v1[2], v1[3]);
                    *(u32x4*)(p.YS + (size_t)row * D + colb + bj * HALF) = w; } }
    }
};
__global__ __launch_bounds__(512, 2) void k_fourx(P p) { GFourX g{p, 4096, 4096, 4096, (int)gridDim.x, (int)blockIdx.x, 0}; gemm_phase((LAS unsigned char*)dyn_smem, g); }
__global__ __launch_bounds__(512, 2) void k_foury(P p) { GFourY g{p, 512, 512, 512, (int)gridDim.x, (int)blockIdx.x, 0}; gemm_phase((LAS unsigned char*)dyn_smem, g); }
__global__ __launch_bounds__(512, 2) void k_merge(P p, int l, int nM) { GMerge g{p, l, nM, 1536, 512, 512, (int)gridDim.x, (int)blockIdx.x, 0}; gemm_phase((LAS unsigned char*)dyn_smem, g); }
__global__ __launch_bounds__(512, 2) void k_out(P p, int l, int nM) { GOut g{p, l, nM, D, D, D, (int)gridDim.x, (int)blockIdx.x, 0}; gemm_phase((LAS unsigned char*)dyn_smem, g); }
__global__ __launch_bounds__(512, 2) void k_gateup(P p, int l) { LAS int* mtb = (LAS int*)((LAS unsigned char*)dyn_smem + LDS_SCRATCH); moe_tiles(p, l, mtb);
    GGateUp g{p, mtb, l, D, D, D, (int)gridDim.x, (int)blockIdx.x}; gemm_phase((LAS unsigned char*)dyn_smem, g); }
__global__ __launch_bounds__(512, 2) void k_down(P p, int l) { LAS int* mtb = (LAS int*)((LAS unsigned char*)dyn_smem + LDS_SCRATCH); moe_tiles(p, l, mtb);
    GDown g{p, mtb, l, D, D, D, (int)gridDim.x, (int)blockIdx.x}; gemm_phase((LAS unsigned char*)dyn_smem, g); }


typedef float f32x16 __attribute__((ext_vector_type(16)));
typedef short s16x4 __attribute__((ext_vector_type(4)));
__device__ __forceinline__ int crow(int r, int hi) { return (r & 3) + 8 * (r >> 2) + 4 * hi; }
__device__ __forceinline__ s16x4 vtr(const LAS unsigned char* q) { return __builtin_bit_cast(s16x4, __builtin_amdgcn_ds_read_tr16_b64_v4i16((LAS s16x4*)q)); }
constexpr int AT_WSF = 139264, AT_TAB = AT_WSF + 2048, AT_X1 = 73728;
template <int MODE>
__device__ __forceinline__ void attn_unit(const P& p, int l, LAS unsigned char* lds, int h, int qrow0, int kb0, int n0, int kb1, int n1, int R0, int j0) {
    constexpr int DV = MODE == 0 ? 128 : 64, ND = DV / 32, KB = MODE == 0 ? 16384 : 8192, VB = DV * 64 * 2, SLOT = KB + VB;
    constexpr float C2 = 0.125f * 1.4426950408889634f;
    const int tid = threadIdx.x, lane = tid & 63, r32 = lane & 31, hi = lane >> 5, wid = __builtin_amdgcn_readfirstlane(tid >> 6);
    const int msub = MODE == 0 ? (wid >> 2) : 0;
    const int qbase = qrow0 + (MODE == 0 ? 32 * (wid & 3) : 32 * wid);
    const int qcol = MODE == 0 ? h * 128 + msub * 64 : 1536 + h * 64;
    const int kcol = MODE == 0 ? 512 + h * 128 : 2048 + h * 64;
    const int vcol = MODE == 0 ? 1024 + h * 128 : 2560 + h * 64;
    bf16x8 qr[4];
#pragma unroll
    for (int d0 = 0; d0 < 4; ++d0) qr[d0] = *(const bf16x8*)(p.QKV + (size_t)(qbase + r32) * 3072 + qcol + d0 * 16 + hi * 8);
    int r_w = 0, rs_w = 0, qc = 0, cs = 0;
    if (MODE == 1) { r_w = R0 + (wid >> 1); rs_w = min(max(r_w - 4, 0), 24); qc = 32 * (wid & 1) + r32; cs = min(max(qc - 8, 0), 48); }
    LAS float* wsf = (LAS float*)(lds + AT_WSF + wid * 256);
    LAS float* tab = (LAS float*)(lds + AT_TAB);
    if (MODE == 1) { for (int i = tid; i < 768; i += 512) { const int idx = i - 64; float v = 0.f;
            if (idx >= 0 && idx < 480) { const int dr = idx >> 5, dc = idx & 31; if (dc < 31) v = p.na_rpb[((size_t)(l * 8 + h) * 15 + dr) * 31 + dc] * 1.4426950408889634f; }
            tab[i] = v; } }
    const int NT = n0 + n1;
    auto issue = [&](int t, int s) {
        const int tb = t < n0 ? kb0 + 64 * t : kb1 + 64 * (t - n0);
        LAS unsigned char* slot = lds + s * SLOT;
        if (MODE == 0) {
#pragma unroll
            for (int i = 0; i < 2; ++i) { const int id = wid * 2 + i;
                __builtin_amdgcn_global_load_lds((const unsigned*)(p.QKV + (size_t)(tb + lane) * 3072 + kcol + (id >> 3) * 64 + (id & 7) * 8), (LAS unsigned*)(slot + (id >> 3) * 8192 + (id & 7) * 1024), 16, 0, 0);
                __builtin_amdgcn_global_load_lds((const unsigned*)(p.QKV + (size_t)(tb + 16 * (id & 3) + (lane >> 2)) * 3072 + vcol + 32 * (id >> 2) + (lane & 3) * 8), (LAS unsigned*)(slot + KB + (id >> 2) * 4096 + (id & 3) * 1024), 16, 0, 0); }
        } else {
            __builtin_amdgcn_global_load_lds((const unsigned*)(p.QKV + (size_t)(tb + lane) * 3072 + kcol + wid * 8), (LAS unsigned*)(slot + wid * 1024), 16, 0, 0);
            __builtin_amdgcn_global_load_lds((const unsigned*)(p.QKV + (size_t)(tb + 16 * (wid & 3) + (lane >> 2)) * 3072 + vcol + 32 * (wid >> 2) + (lane & 3) * 8), (LAS unsigned*)(slot + KB + (wid >> 2) * 4096 + (wid & 3) * 1024), 16, 0, 0);
        }
    };
    f32x16 o[ND];
#pragma unroll
    for (int d0 = 0; d0 < ND; ++d0)
#pragma unroll
        for (int r = 0; r < 16; ++r) o[d0][r] = 0.f;
    float mref = -1e30f, lsum = 0.f;
    issue(0, 0);
    for (int t = 0; t < NT; ++t) {
        asm volatile("s_waitcnt vmcnt(0)" ::: "memory");
        __syncthreads();
        if (t + 1 < NT) issue(t + 1, (t + 1) & 1);
        bool act = true; int dr = 0; const bool nb = (MODE == 1) && (t < n0);
        if (nb) { const int j = j0 + t; act = (j >= rs_w) && (j < rs_w + 8); dr = j - r_w + 7; }
        if (act) {
            const LAS unsigned char* Ks = lds + (t & 1) * SLOT + msub * 8192;
            const LAS unsigned char* Vs = lds + (t & 1) * SLOT + KB;
            f32x16 p0, p1;
#pragma unroll
            for (int r = 0; r < 16; ++r) { p0[r] = 0.f; p1[r] = 0.f; }
            const LAS unsigned char* kp = Ks + hi * 1024 + r32 * 16;
#pragma unroll
            for (int d0 = 0; d0 < 4; ++d0) { const bf16x8 b0 = *(const LAS bf16x8*)(kp + d0 * 2048), b1 = *(const LAS bf16x8*)(kp + d0 * 2048 + 512);
                p0 = __builtin_amdgcn_mfma_f32_32x32x16_bf16(b0, qr[d0], p0, 0, 0, 0); p1 = __builtin_amdgcn_mfma_f32_32x32x16_bf16(b1, qr[d0], p1, 0, 0, 0); }
            if (nb) { const LAS float* tb_ = tab + 64 + dr * 32 + 4 * hi - qc + 15; const int kbase = 4 * hi - cs;
#pragma unroll
                for (int r = 0; r < 16; ++r) { const int ko = (r & 3) + 8 * (r >> 2);
                    p0[r] = ((unsigned)(kbase + ko) < 16u) ? p0[r] * C2 + tb_[ko] : -1e30f;
                    p1[r] = ((unsigned)(kbase + ko + 32) < 16u) ? p1[r] * C2 + tb_[ko + 32] : -1e30f; }
            } else {
#pragma unroll
                for (int r = 0; r < 16; ++r) { p0[r] *= C2; p1[r] *= C2; } }
            float rm = fmaxf(p0[0], p1[0]);
#pragma unroll
            for (int r = 1; r < 16; ++r) rm = fmaxf(rm, fmaxf(p0[r], p1[r]));
            rm = fmaxf(rm, __shfl_xor(rm, 32));
            if (__any(rm > mref + 8.f)) {
                const float mn = fmaxf(mref, rm); const float f = __builtin_amdgcn_exp2f(mref - mn); mref = mn; lsum *= f;
                if (hi == 0) wsf[r32] = f;
                __builtin_amdgcn_s_waitcnt(0xc07f);
#pragma unroll
                for (int r = 0; r < 16; ++r) { const float fr_ = wsf[crow(r, hi)];
#pragma unroll
                    for (int d0 = 0; d0 < ND; ++d0) o[d0][r] *= fr_; }
            }
            float ls = 0.f;
#pragma unroll
            for (int r = 0; r < 16; ++r) { p0[r] = __builtin_amdgcn_exp2f(p0[r] - mref); p1[r] = __builtin_amdgcn_exp2f(p1[r] - mref); ls += p0[r] + p1[r]; }
            lsum += ls;
            u32x4 pw[4];
#pragma unroll
            for (int k = 0; k < 2; ++k) {
                pw[k] = (u32x4){cvt_pk_bf16(p0[8 * k], p0[8 * k + 1]), cvt_pk_bf16(p0[8 * k + 2], p0[8 * k + 3]), cvt_pk_bf16(p0[8 * k + 4], p0[8 * k + 5]), cvt_pk_bf16(p0[8 * k + 6], p0[8 * k + 7])};
                pw[2 + k] = (u32x4){cvt_pk_bf16(p1[8 * k], p1[8 * k + 1]), cvt_pk_bf16(p1[8 * k + 2], p1[8 * k + 3]), cvt_pk_bf16(p1[8 * k + 4], p1[8 * k + 5]), cvt_pk_bf16(p1[8 * k + 6], p1[8 * k + 7])}; }
            const LAS unsigned char* vp = Vs + ((lane >> 4) & 1) * 32 + (lane & 3) * 8 + (4 * hi + ((lane & 15) >> 2)) * 64;
#pragma unroll
            for (int d0 = 0; d0 < ND; ++d0)
#pragma unroll
                for (int ks = 0; ks < 4; ++ks) { const s16x4 lo = vtr(vp + d0 * 4096 + ks * 1024), hh = vtr(vp + d0 * 4096 + ks * 1024 + 512);
                    const bf16x8 vf = (bf16x8){lo[0], lo[1], lo[2], lo[3], hh[0], hh[1], hh[2], hh[3]};
                    o[d0] = __builtin_amdgcn_mfma_f32_32x32x16_bf16(__builtin_bit_cast(bf16x8, pw[ks]), vf, o[d0], 0, 0, 0); }
        }
    }
    lsum += __shfl_xor(lsum, 32);
    __syncthreads();
    float fac = 1.f / lsum;
    if (MODE == 0 && msub == 1) fac *= p.LAM[l];
    if (hi == 0) wsf[r32] = fac;
    __builtin_amdgcn_s_waitcnt(0xc07f);
    float rl[16];
#pragma unroll
    for (int r = 0; r < 16; ++r) rl[r] = wsf[crow(r, hi)];
    if (MODE == 0) {
        LAS float* x1 = (LAS float*)(lds + AT_X1) + (wid & 3) * 4096 + lane;
        if (msub == 1) {
#pragma unroll
            for (int d0 = 0; d0 < ND; ++d0)
#pragma unroll
                for (int r = 0; r < 16; ++r) x1[(d0 * 16 + r) * 64] = o[d0][r] * rl[r];
        }
        __syncthreads();
        if (msub == 0) {
            LAS float* st = (LAS float*)(lds + wid * 16896);
#pragma unroll
            for (int d0 = 0; d0 < ND; ++d0)
#pragma unroll
                for (int r = 0; r < 16; ++r) st[crow(r, hi) * 132 + d0 * 32 + r32] = o[d0][r] * rl[r] - x1[(d0 * 16 + r) * 64];
            __builtin_amdgcn_s_waitcnt(0xc07f);
            const int q = lane >> 1, half = lane & 1;
            f32x4 v[16]; float ss = 0.f;
#pragma unroll
            for (int i = 0; i < 16; ++i) { v[i] = *(const LAS f32x4*)(st + q * 132 + half * 64 + i * 4); ss += v[i][0] * v[i][0] + v[i][1] * v[i][1] + v[i][2] * v[i][2] + v[i][3] * v[i][3]; }
            ss += __shfl_xor(ss, 1);
            const float rn = rsqrtf(ss * (1.f / 128.f) + EPS) * (1.f - (0.8f - 0.6f * __expf(-0.3f * (float)l)));
            const float* g = p.da_subln_g + l * 128 + half * 64;
            bf16_t* dst = p.O + (size_t)(qbase + q) * 1536 + h * 128 + half * 64;
#pragma unroll
            for (int i = 0; i < 8; ++i) { const f32x4 ga = *(const f32x4*)(g + i * 8), gb = *(const f32x4*)(g + i * 8 + 4); const f32x4 a = v[2 * i] * ga * rn, b = v[2 * i + 1] * gb * rn;
                u32x4 w; w.x = cvt_pk_bf16(a[0], a[1]); w.y = cvt_pk_bf16(a[2], a[3]); w.z = cvt_pk_bf16(b[0], b[1]); w.w = cvt_pk_bf16(b[2], b[3]);
                *(u32x4*)(dst + i * 8) = w; }
        }
    } else {
        LAS bf16_t* stg = (LAS bf16_t*)(lds + AT_X1 + wid * 4096);
#pragma unroll
        for (int r = 0; r < 16; ++r)
#pragma unroll
            for (int d0 = 0; d0 < ND; ++d0) stg[crow(r, hi) * 64 + d0 * 32 + r32] = f2bf(o[d0][r] * rl[r]);
        __builtin_amdgcn_s_waitcnt(0xc07f);
#pragma unroll
        for (int i = 0; i < 4; ++i) { const int row = i * 8 + (lane >> 3), ch = lane & 7; const u32x4 v = *(const LAS u32x4*)(stg + row * 64 + ch * 8);
            *(u32x4*)(p.O + (size_t)(qbase + row) * 1536 + 512 + h * 64 + ch * 8) = v; }
    }
    __syncthreads();
}
__device__ __forceinline__ void attn_phase(const P& p, int l, bool last, LAS unsigned char* lds, int G, int c) {
    for (int u = c; u < 512; u += G) { const int b = u >> 6, h = (u >> 4) & 3, qb = u & 15;
        attn_unit<0>(p, l, lds, h, b * SEQ + qb * 128, b * SEQ, 32, TX + b * CTX, 4, 0, 0); }
    for (int u = c; u < 512; u += G) { const int b = u >> 6, h = (u >> 3) & 7, R0 = (u & 7) * 4;
        const int j0 = min(max(R0 - 4, 0), 24), je = min(max(R0 - 1, 0), 24) + 8;
        attn_unit<1>(p, l, lds, h, b * SEQ + R0 * 64, b * SEQ + j0 * 64, je - j0, TX + b * CTX, 4, R0, j0); }
    if (!last) {
        for (int u = c; u < 64; u += G) { const int b = u >> 3, h = (u >> 1) & 3, qb = u & 1;
            attn_unit<0>(p, l, lds, h, TX + b * CTX + qb * 128, TX + b * CTX, 4, 0, 0, 0, 0); }
        for (int u = c; u < 64; u += G) { const int b = u >> 3, h = u & 7;
            attn_unit<2>(p, l, lds, h, TX + b * CTX, TX + b * CTX, 4, 0, 0, 0, 0); }
    }
}
__global__ __launch_bounds__(512, 2) void k_attn(P p, int l, int last) { attn_phase(p, l, last != 0, (LAS unsigned char*)dyn_smem, (int)gridDim.x, (int)blockIdx.x); }

static inline size_t al256(size_t v) { return (v + 255) & ~(size_t)255; }
extern "C" void kernel_launch(void* const* d_in, const int* in_sizes, int n_in, void* d_out, int out_size, void* d_ws, size_t ws_size, hipStream_t stream) {
    P p{};
    p.x = (const float*)d_in[0]; p.c = (const float*)d_in[1]; p.ctx = (const float*)d_in[2]; p.c_ctx = (const float*)d_in[3]; p.w_mod = (const float*)d_in[4]; p.b_mod = (const float*)d_in[5];
    p.nmg = (const float*)d_in[6]; p.nfg = (const float*)d_in[7]; p.w_in = (const float*)d_in[8]; p.da_lambda = (const float*)d_in[9]; p.da_subln_g = (const float*)d_in[10]; p.na_rpb = (const float*)d_in[11];
    p.w_branch = (const float*)d_in[12]; p.w_out = (const float*)d_in[13]; p.w_router = (const float*)d_in[14]; p.b_router = (const float*)d_in[15]; p.w_gu = (const float*)d_in[16]; p.b_gu = (const float*)d_in[17];
    p.w_dn = (const float*)d_in[18]; p.b_dn = (const float*)d_in[19]; p.final_g = (const float*)d_in[20]; p.out = (float*)d_out;
    char* ws = (char*)d_ws; size_t off = 0;
    auto take = [&](size_t bytes) { char* r = ws + off; off = al256(off + bytes); return r; };
    int* ctl = (int*)take(65536);
    p.CNT = ctl;
    p.X = (float*)take((size_t)T * D * 4); p.MOD = (float*)take((size_t)DEPTH * 9 * NMOD * 4); p.LAM = (float*)take(256); p.ROPE = (float*)take((size_t)2 * SEQ * 32 * 4);
    p.H1 = (bf16_t*)take((size_t)T * D * 2); p.QKV = (bf16_t*)take((size_t)T * 3072 * 2); p.G = (bf16_t*)take((size_t)T * 3072 * 2); p.F = (float*)take((size_t)T * 512 * 4);
    p.FtX = (bf16_t*)take((size_t)NB * 512 * 4096 * 2); p.FtY = (bf16_t*)take((size_t)NB * 512 * 512 * 2); p.CSX = (bf16_t*)take((size_t)2048 * 4096 * 2); p.CSY = (bf16_t*)take((size_t)256 * 512 * 2);
    p.O = (bf16_t*)take((size_t)T * 1536 * 2); p.Mf = (float*)take((size_t)T * D * 4); p.Mg = (bf16_t*)take((size_t)T * D * 2);
    p.ROWIDX = (int*)take((size_t)T * 4 * 4); p.SROWW = (float*)take((size_t)NEXP * CAP * 4);
    p.H2S = (bf16_t*)take((size_t)NEXP * CAP * D * 2); p.YS = p.H2S; p.ACT = (bf16_t*)take((size_t)NEXP * CAP * D * 2);
    p.WinT = (bf16_t*)take((size_t)DEPTH * 7168 * D * 2); p.WbT = (bf16_t*)take((size_t)DEPTH * 3 * D * 512 * 2); p.WoT = (bf16_t*)take((size_t)DEPTH * D * D * 2);
    p.WguT = (bf16_t*)take((size_t)DEPTH * NEXP * 2048 * D * 2); p.WdT = (bf16_t*)take((size_t)DEPTH * NEXP * D * D * 2);
    if (off > ws_size) { fprintf(stderr, "workspace too small: need %zu have %zu\n", off, ws_size); return; }
    hipMemsetAsync(ctl, 0, 65536, stream);
    k_mod<<<dim3(96, 4), 256, 0, stream>>>(p);
    k_lam<<<1, 256, 0, stream>>>(p);
    k_rope_tab<<<SEQ * 32 / 256, 256, 0, stream>>>(p);
    k_dft_tab<<<2048 * 4096 / 256, 256, 0, stream>>>(p);
    k_initx<<<T, 256, 0, stream>>>(p);
    static bool attr_done = false;
    if (!attr_done) { const void* ks[] = {(const void*)k_inproj, (const void*)k_fourx, (const void*)k_foury, (const void*)k_merge, (const void*)k_out, (const void*)k_gateup, (const void*)k_down, (const void*)k_attn};
        for (const void* k : ks) (void)hipFuncSetAttribute(k, hipFuncAttributeMaxDynamicSharedMemorySize, LDS_TOTAL); attr_done = true; }
    k_tcvt<<<dim3(D / 64, 512 / 64, DEPTH * 3), 256, 0, stream>>>(p.w_branch, p.WbT, D, 512, (size_t)512 * D, (size_t)D * 512);
    k_tcvt<<<dim3(D / 64, D / 64, DEPTH), 256, 0, stream>>>(p.w_out, p.WoT, D, D, (size_t)D * D, (size_t)D * D);
    k_tcvt<<<dim3(2048 / 64, D / 64, DEPTH * NEXP), 256, 0, stream>>>(p.w_gu, p.WguT, 2048, D, (size_t)D * 2048, (size_t)2048 * D);
    k_tcvt<<<dim3(D / 64, D / 64, DEPTH * NEXP), 256, 0, stream>>>(p.w_dn, p.WdT, D, D, (size_t)D * D, (size_t)D * D);
    k_tcvt<<<dim3(3072 / 64, D / 64, DEPTH), 256, 0, stream>>>(p.w_in, p.WinT, INC, D, (size_t)D * INC, (size_t)7168 * D);
    k_tcvt<<<dim3(3072 / 64, D / 64, DEPTH), 256, 0, stream>>>(p.w_in + 3584, p.WinT + (size_t)4096 * D, INC, D, (size_t)D * INC, (size_t)7168 * D);
    k_wucus<<<dim3(1024 * 512 / 256, DEPTH), 256, 0, stream>>>(p);
    for (int l = 0; l < DEPTH; ++l) {
        const bool last = l == DEPTH - 1; const int Tm = last ? TX : T;
        k_norm1<<<T / 4, 256, 0, stream>>>(p, l);
#if FAST_INPROJ
        k_inproj<<<256, 512, LDS_TOTAL, stream>>>(p, l);
#else
        nv_gemm<false, false, FInproj><<<dim3(INC / 64, T / 64, 1), 256, 0, stream>>>(FInproj{p, l, 0}, D);
        nv_rope<<<TX * 512 / 256, 256, 0, stream>>>(p);
        nv_chan_dft<<<T * 512 / 256, 256, 0, stream>>>(p);
#endif
#if FAST_ATTN
        k_attn<<<256, 512, LDS_TOTAL, stream>>>(p, l, last ? 1 : 0);
#else
        nv_diffattn<<<dim3(TX, 4), 256, 0, stream>>>(p, l, 0);
        nv_na<<<dim3(TX, 8), 256, 0, stream>>>(p, l, 0);
#endif
#if FAST_FOUR
        k_fourx<<<256, 512, LDS_TOTAL, stream>>>(p);
#else
        nv_gemm<true, false, FFourX><<<dim3(512 / 64, SEQ / 64, NB), 256, 0, stream>>>(FFourX{p}, 4096);
#endif
        if (!last) {
#if !FAST_ATTN
            nv_diffattn<<<dim3(TY, 4), 256, 0, stream>>>(p, l, TX);
            nv_na<<<dim3(TY, 8), 256, 0, stream>>>(p, l, TX);
#endif
#if FAST_FOUR
            k_foury<<<256, 512, LDS_TOTAL, stream>>>(p);
#else
            nv_gemm<true, false, FFourY><<<dim3(512 / 64, CTX / 64, NB), 256, 0, stream>>>(FFourY{p}, 512);
#endif
        }
#if FAST_MERGE
        k_merge<<<256, 512, LDS_TOTAL, stream>>>(p, l, Tm / 256);
#else
        for (int i = 0; i < 3; ++i) nv_gemm<false, false, FMerge><<<dim3(D / 64, Tm / 64, 1), 256, 0, stream>>>(FMerge{p, l, i, Tm, 0}, 512);
#endif
#if FAST_OUT
        k_out<<<256, 512, LDS_TOTAL, stream>>>(p, l, Tm / 256);
#else
        nv_gemm<false, false, FOut><<<dim3(D / 64, Tm / 64, 1), 256, 0, stream>>>(FOut{p, l, Tm}, D);
#endif
        k_norm2_route<<<Tm / 4, 256, 0, stream>>>(p, l);
#if FAST_MOE
        k_gateup<<<256, 512, LDS_TOTAL, stream>>>(p, l);
        k_down<<<256, 512, LDS_TOTAL, stream>>>(p, l);
#else
        nv_gemm<false, true, FGateUp><<<dim3(D / 64, CAP / 64, NEXP), 256, 0, stream>>>(FGateUp{p, l, 0}, D);
        nv_gemm<false, false, FDown><<<dim3(D / 64, CAP / 64, NEXP), 256, 0, stream>>>(FDown{p, l, 0}, D);
#endif
        k_combine<<<Tm / 4, 256, 0, stream>>>(p, l);
    }
    k_final<<<TX / 4, 256, 0, stream>>>(p);
}
```

```cpp
#include <hip/hip_runtime.h>
#include <hip/hip_bf16.h>
#include <stdint.h>
#include <stdio.h>
#ifndef REP_PRO
#define REP_PRO 1
#endif
#ifndef REP_INP
#define REP_INP 1
#endif
#ifndef REP_MIX
#define REP_MIX 1
#endif
#ifndef REP_MG
#define REP_MG 1
#endif
#ifndef REP_GU
#define REP_GU 1
#endif
#ifndef REP_DN
#define REP_DN 1
#endif
#ifndef REP_N2
#define REP_N2 1
#endif
#ifndef REP_GU_CHEAP
#define REP_GU_CHEAP 0
#endif
#ifndef REP_FX
#define REP_FX 1
#endif
#ifndef REP_PV
#define REP_PV 1
#endif
#ifndef REP_XP
#define REP_XP 1
#endif
#ifndef REP_DMA
#define REP_DMA 1
#endif
#ifndef REP_DA
#define REP_DA 1
#endif
#ifndef REP_NA
#define REP_NA 1
#endif
#ifndef TAIL_CVT
#define TAIL_CVT 1
#endif
#ifndef REP_OUT
#define REP_OUT 1
#endif
#ifndef REP_N1
#define REP_N1 1
#endif
#ifndef REP_BAR
#define REP_BAR 1
#endif

typedef unsigned short bf16_t;
__device__ __forceinline__ float bf2f(bf16_t v) { return __uint_as_float(((unsigned)v) << 16); }
__device__ __forceinline__ bf16_t f2bf(float f) { unsigned u = __float_as_uint(f); u += 0x7FFFu + ((u >> 16) & 1u); return (bf16_t)(u >> 16); }
__device__ __forceinline__ float4 ldx4(const bf16_t* p) { const uint2 u = *(const uint2*)p; return make_float4(__uint_as_float(u.x << 16), __uint_as_float(u.x & 0xffff0000u), __uint_as_float(u.y << 16), __uint_as_float(u.y & 0xffff0000u)); }

constexpr int D = 1024, NB = 8, SEQ = 2048, CTX = 256, TX = NB * SEQ, TY = NB * CTX, T = TX + TY, DEPTH = 4;
constexpr int NMOD = 6 * D, INC = 6656, NEXP = 32, CAP = T;
constexpr float EPS = 1e-6f;
constexpr float QSCALE = 0.125f * 1.4426950408889634f;

constexpr size_t al256c(size_t v) { return (v + 255) & ~(size_t)255; }
constexpr size_t OFF_CTL = 0, SZ_CTL = 65536;
constexpr size_t OFF_X = al256c(OFF_CTL + SZ_CTL);
constexpr size_t OFF_MOD = al256c(OFF_X + (size_t)T * D * 4);
constexpr size_t OFF_LAM = al256c(OFF_MOD + (size_t)DEPTH * 9 * NMOD * 4);
constexpr size_t OFF_ROPE = al256c(OFF_LAM + 256);
constexpr size_t OFF_H1 = al256c(OFF_ROPE + (size_t)2 * SEQ * 32 * 4);
constexpr size_t OFF_QKV = al256c(OFF_H1 + (size_t)T * D * 2);
constexpr size_t OFF_G = al256c(OFF_QKV + (size_t)T * 3072 * 2);
constexpr size_t OFF_FTX = al256c(OFF_G + (size_t)T * 3072 * 2);
constexpr size_t OFF_FTY = al256c(OFF_FTX + (size_t)NB * 512 * 4096 * 2);
constexpr size_t OFF_CSX = al256c(OFF_FTY + (size_t)NB * 512 * 512 * 2);
constexpr size_t OFF_CSY = al256c(OFF_CSX + (size_t)2048 * 4096 * 2);
constexpr size_t OFF_O = al256c(OFF_CSY + (size_t)256 * 512 * 2);
constexpr size_t OFF_MF = al256c(OFF_O + (size_t)T * 1536 * 2);
constexpr size_t OFF_MG = al256c(OFF_MF + (size_t)T * D * 4);
constexpr size_t OFF_ROWIDX = al256c(OFF_MG + (size_t)T * D * 2);
constexpr size_t OFF_SROWW = al256c(OFF_ROWIDX + (size_t)T * 4 * 4);
constexpr size_t OFF_H2S = al256c(OFF_SROWW + (size_t)NEXP * CAP * 4);
constexpr size_t OFF_ACT = al256c(OFF_H2S + (size_t)NEXP * CAP * D * 2);
constexpr size_t OFF_WINT = al256c(OFF_ACT + (size_t)NEXP * CAP * D * 2);
constexpr size_t OFF_WBT = al256c(OFF_WINT + (size_t)DEPTH * 7168 * D * 2);
constexpr size_t OFF_WOT = al256c(OFF_WBT + (size_t)DEPTH * 3 * D * 512 * 2);
constexpr size_t OFF_WGUT = al256c(OFF_WOT + (size_t)DEPTH * D * D * 2);
constexpr size_t OFF_WDT = al256c(OFF_WGUT + (size_t)DEPTH * NEXP * 2048 * D * 2);
constexpr size_t OFF_WF = al256c(OFF_WDT + (size_t)DEPTH * NEXP * D * D * 2);
constexpr size_t OFF_DFTC = al256c(OFF_WF + (size_t)DEPTH * D * 512 * 2);
constexpr size_t OFF_WRH = al256c(OFF_DFTC + (size_t)1024 * 512 * 2);
constexpr size_t OFF_WRL = al256c(OFF_WRH + (size_t)DEPTH * NEXP * D * 2);
constexpr size_t OFF_LIST = al256c(OFF_WRL + (size_t)DEPTH * NEXP * D * 2);
constexpr size_t WS_NEED = al256c(OFF_LIST + (size_t)NEXP * CAP * 4);
struct P {
    const float *x, *c, *ctx, *c_ctx, *w_mod, *b_mod, *nmg, *nfg, *w_in, *da_lambda, *da_subln_g, *na_rpb, *w_branch, *w_out, *w_router, *b_router, *w_gu, *b_gu, *w_dn, *b_dn, *final_g;
    float* out; char* ws;
#define WSF(name, type, off) __device__ __forceinline__ type* name() const { return (type*)(ws + (off)); }
    WSF(X, bf16_t, OFF_X) WSF(MOD, float, OFF_MOD) WSF(LAM, float, OFF_LAM) WSF(Mf, float, OFF_MF) WSF(ROPE, float, OFF_ROPE) WSF(SROWW, float, OFF_SROWW)
    WSF(H1, bf16_t, OFF_H1) WSF(QKV, bf16_t, OFF_QKV) WSF(G, unsigned char, OFF_G) WSF(FtX, bf16_t, OFF_FTX) WSF(FtY, bf16_t, OFF_FTY) WSF(CSX, bf16_t, OFF_CSX) WSF(CSY, bf16_t, OFF_CSY)
    WSF(O, bf16_t, OFF_O) WSF(Mg, bf16_t, OFF_MG) WSF(H2S, bf16_t, OFF_H2S) WSF(ACT, bf16_t, OFF_ACT) WSF(YS, bf16_t, OFF_H2S)
    WSF(WinT, bf16_t, OFF_WINT) WSF(WbT, bf16_t, OFF_WBT) WSF(WoT, bf16_t, OFF_WOT) WSF(WguT, bf16_t, OFF_WGUT) WSF(WdT, bf16_t, OFF_WDT) WSF(Wf, bf16_t, OFF_WF) WSF(DFTC, bf16_t, OFF_DFTC) WSF(WrH, bf16_t, OFF_WRH) WSF(WrL, bf16_t, OFF_WRL) WSF(LIST, int, OFF_LIST)
    WSF(CNT, int, OFF_CTL) WSF(QCTR, int, OFF_CTL + 1024) WSF(XQ, int, OFF_CTL + 32768) WSF(SIG, int, OFF_CTL + 2048) WSF(ROWIDX, int, OFF_ROWIDX) WSF(bar, unsigned, OFF_CTL + 8192)
#undef WSF
};

__device__ __forceinline__ int otid() { int t = threadIdx.x; asm volatile("" : "+v"(t)); return t; }
__device__ __forceinline__ float wave_sum(float v) { for (int o = 32; o; o >>= 1) v += __shfl_xor(v, o); return v; }
__device__ __forceinline__ int modidx(int row) { return row < TX ? row / SEQ : NB; }

#define LAS __attribute__((address_space(3)))
typedef short bf16x8 __attribute__((ext_vector_type(8)));
typedef float f32x4 __attribute__((ext_vector_type(4)));
typedef unsigned u32x4 __attribute__((ext_vector_type(4)));
constexpr int BM = 256, BK = 64, HALF = 128, HTB = HALF * BK * 2, STAGE_BYTES = 8 * HTB, NXCD = 8, WGM = 8;
constexpr int LDS_SCRATCH = STAGE_BYTES, LDS_TOTAL = STAGE_BYTES + 16384 + 2048;
extern __shared__ __attribute__((aligned(16))) unsigned char dyn_smem[];
__device__ __forceinline__ int lds_byte(int r, int c) { const int st = (r >> 4) * 2 + (c >> 5), rr = r & 15, cc = c & 31, ob = rr * 64 + cc * 2; return st * 1024 + (ob ^ (((ob >> 9) & 1) << 5)); }
__device__ __forceinline__ void stage_rc(int b, int& R, int& C) { const int st = b / 1024, sb = b % 1024, swz = sb ^ (((sb >> 9) & 1) << 5); R = (st >> 1) * 16 + swz / 64; C = (st & 1) * 32 + (swz % 64) / 2; }
__device__ __forceinline__ int perm32(int rho) { const int n = rho >> 4, i = rho & 15; return 8 * (i >> 2) + 4 * n + (i & 3); }
typedef float f32x2_t __attribute__((ext_vector_type(2)));
typedef __bf16 bf16x2_t __attribute__((ext_vector_type(2)));
__device__ __forceinline__ unsigned cvt_pk_bf16(float lo, float hi) { const f32x2_t v = {lo, hi}; const bf16x2_t b = __builtin_convertvector(v, bf16x2_t); return __builtin_bit_cast(unsigned, b); }
__device__ __forceinline__ unsigned sig255_(float v) { return (unsigned)__builtin_amdgcn_rcpf(__builtin_fmaf(__builtin_amdgcn_exp2f(v * -1.4426950408889634f), 1.f / 255.f, 1.f / 255.f)); }
__device__ __forceinline__ float sigmoidf_(float v) { return __builtin_amdgcn_rcpf(1.f + __builtin_amdgcn_exp2f(v * -1.4426950408889634f)); }

struct GUnit { const char *a0, *a1, *b0, *b1; int pm, pn, e, pad; };
constexpr int PRE_SLOT = 8 * 768;
__device__ __forceinline__ bool static_tile(int L, int nM, int nN, int& pm, int& pn) {
    const int nwg = nM * nN; if (L >= nwg) return false;
    int wgid = L; { const int q = nwg / NXCD, r = nwg % NXCD, xcd = wgid % NXCD, off = wgid / NXCD; wgid = (xcd < r ? xcd * (q + 1) : r * (q + 1) + (xcd - r) * q) + off; }
    const int nig = WGM * nN, gid = wgid / nig, fm = gid * WGM, gsz = (nM - fm) < WGM ? (nM - fm) : WGM;
    pm = fm + ((wgid % nig) % gsz); pn = (wgid % nig) / gsz; return true;
}

template <class G>
__device__ __forceinline__ void gemm_phase(LAS unsigned char* lds, const G& g) {
    const int tid = otid(), wid = __builtin_amdgcn_readfirstlane(tid >> 6), lane = tid & 63, wr = wid >> 2, wc = wid & 3, fr = lane & 15, fq = lane >> 4;
    const int nt = g.K / BK;
    unsigned voffA[2], voffB[2]; int stR[2], stC2[2];
#pragma unroll
    for (int i = 0; i < 2; ++i) { int R, C; stage_rc(tid * 16 + i * 8192, R, C); const int Rb = G::PERM ? ((R & ~31) + perm32(R & 31)) : R; stR[i] = R; stC2[i] = C * 2;
        voffA[i] = (unsigned)(R * g.lda + C) * 2u; voffB[i] = (unsigned)(Rb * g.ldb + C) * 2u; }
    unsigned vc0[2] = {voffA[0], voffA[1]}, vc1[2] = {voffA[0], voffA[1]}, vn0[2] = {voffA[0], voffA[1]}, vn1[2] = {voffA[0], voffA[1]};
    const size_t kstep = (size_t)(BK * 2);
    const unsigned ldsw = (unsigned)wid * 1024u;
    const int aoff = lds_byte(wr * 64 + fr, fq * 8), boff = lds_byte(wc * 32 + fr, fq * 8);
#define PG8_SA(b, h) (((b) * 2 + (h)) * HTB)
#define PG8_SB(b, h) ((4 + (b) * 2 + (h)) * HTB)
#define PG8_STAGE(bufoff, gbase, voff) do { _Pragma("unroll") for (int _i = 0; _i < 2; ++_i) \
        __builtin_amdgcn_global_load_lds((const unsigned*)((const char*)(gbase) + (voff)[_i]), (LAS unsigned*)(lds + (bufoff) + ldsw + _i * 8192), 16, 0, 0); } while (0)
#define PG8_LDA(dst, b, h) do { _Pragma("unroll") for (int m = 0; m < 4; ++m) _Pragma("unroll") for (int k = 0; k < 2; ++k) dst[m][k] = *(const LAS bf16x8*)(lds + PG8_SA(b, h) + aoff + m * 2048 + k * 1024); } while (0)
#define PG8_LDB(dst, b, h) do { _Pragma("unroll") for (int n = 0; n < 2; ++n) _Pragma("unroll") for (int k = 0; k < 2; ++k) dst[n][k] = *(const LAS bf16x8*)(lds + PG8_SB(b, h) + boff + n * 2048 + k * 1024); } while (0)
#define PG8_MMA(ai, bj, At, Bt) do { __builtin_amdgcn_s_setprio(1); _Pragma("unroll") for (int m = 0; m < 4; ++m) _Pragma("unroll") for (int n = 0; n < 2; ++n) _Pragma("unroll") for (int k = 0; k < 2; ++k) \
        acc[ai][bj][m][n] = __builtin_amdgcn_mfma_f32_16x16x32_bf16(Bt[n][k], At[m][k], acc[ai][bj][m][n], 0, 0, 0); __builtin_amdgcn_s_setprio(0); } while (0)
#define PG8_WAIT_V(n) asm volatile("s_waitcnt vmcnt(" #n ")" ::: "memory")
#define PG8_WAIT_L(n) asm volatile("s_waitcnt lgkmcnt(" #n ")" ::: "memory")
#define PG8_BAR __builtin_amdgcn_s_barrier()
#define PG8_SCHED __builtin_amdgcn_sched_barrier(0)
    GUnit cur, nxt; int ui = 0;
    if (!g.next(0, cur)) return;
    if constexpr (G::GATHER) g.gather(cur, stR, stC2, vc0, vc1);
    if constexpr (G::PRE) g.pre(cur, lds, wid, lane, 0);
    f32x4 acc[2][2][4][2];
#pragma unroll
    for (int a = 0; a < 2; ++a)
#pragma unroll
        for (int b = 0; b < 2; ++b)
#pragma unroll
            for (int m = 0; m < 4; ++m)
#pragma unroll
                for (int n = 0; n < 2; ++n) acc[a][b][m][n] = (f32x4){0.f, 0.f, 0.f, 0.f};
    bf16x8 At[4][2], B0[2][2], B1[2][2];
    PG8_STAGE(PG8_SB(0, 0), cur.b0, voffB); PG8_STAGE(PG8_SB(0, 1), cur.b1, voffB); PG8_STAGE(PG8_SA(0, 0), cur.a0, vc0); PG8_STAGE(PG8_SA(0, 1), cur.a1, vc1);
    if (wr == 1) PG8_BAR;
    PG8_WAIT_V(2); PG8_BAR;
    PG8_STAGE(PG8_SB(1, 0), cur.b0 + kstep, voffB); PG8_STAGE(PG8_SA(1, 0), cur.a0 + kstep, vc0); PG8_STAGE(PG8_SB(1, 1), cur.b1 + kstep, voffB);
    PG8_WAIT_V(6); PG8_BAR;
    if constexpr (G::PRE) g.binit(acc, lds, wid, fq, 0);
    for (;;) {
        const bool has_next = g.next(ui + 1, nxt);
        if (!has_next) nxt = cur;
        if constexpr (G::PRE) { if (has_next) g.pre(nxt, lds, wid, lane, (ui + 1) & 1); }
        if constexpr (G::GATHER) { if (has_next) g.gather(nxt, stR, stC2, vn0, vn1); else { vn0[0] = vc0[0]; vn0[1] = vc0[1]; vn1[0] = vc1[0]; vn1[1] = vc1[1]; } }
        for (int t = 0; t < nt; t += 2) {
            const bool last = (t == nt - 2);
            unsigned va0[2], va1[2];
            if constexpr (G::GATHER) { va0[0] = last ? vn0[0] : vc0[0]; va0[1] = last ? vn0[1] : vc0[1]; va1[0] = last ? vn1[0] : vc1[0]; va1[1] = last ? vn1[1] : vc1[1]; }
            else { va0[0] = voffA[0]; va0[1] = voffA[1]; va1[0] = voffA[0]; va1[1] = voffA[1]; }
            const char* a1h1 = cur.a1 + (size_t)(t + 1) * kstep;
            const char* a2_0 = last ? nxt.a0 : cur.a0 + (size_t)(t + 2) * kstep; const char* a2_1 = last ? nxt.a1 : cur.a1 + (size_t)(t + 2) * kstep;
            const char* b2_0 = last ? nxt.b0 : cur.b0 + (size_t)(t + 2) * kstep; const char* b2_1 = last ? nxt.b1 : cur.b1 + (size_t)(t + 2) * kstep;
            PG8_LDB(B0, 0, 0); PG8_LDB(B1, 0, 1); PG8_SCHED; PG8_LDA(At, 0, 0); PG8_STAGE(PG8_SA(1, 1), a1h1, vc1);
            PG8_WAIT_V(8); PG8_WAIT_L(0); PG8_BAR; PG8_MMA(0, 0, At, B0); PG8_MMA(0, 1, At, B1); PG8_BAR; PG8_SCHED;
            PG8_LDA(At, 0, 1); PG8_STAGE(PG8_SB(0, 0), b2_0, voffB); PG8_STAGE(PG8_SB(0, 1), b2_1, voffB); PG8_STAGE(PG8_SA(0, 0), a2_0, va0);
            PG8_WAIT_V(8); PG8_WAIT_L(0); PG8_BAR; PG8_MMA(1, 0, At, B0); PG8_MMA(1, 1, At, B1); PG8_BAR; PG8_SCHED;
            PG8_LDB(B0, 1, 0); PG8_LDB(B1, 1, 1); PG8_SCHED; PG8_LDA(At, 1, 0); PG8_STAGE(PG8_SA(0, 1), a2_1, va1);
            PG8_WAIT_V(8); PG8_WAIT_L(0); PG8_BAR; PG8_MMA(0, 0, At, B0); PG8_MMA(0, 1, At, B1); PG8_BAR; PG8_SCHED;
            PG8_LDA(At, 1, 1); PG8_STAGE(PG8_SB(1, 0), b2_0 + kstep, voffB); PG8_STAGE(PG8_SB(1, 1), b2_1 + kstep, voffB); PG8_STAGE(PG8_SA(1, 0), a2_0 + kstep, va0);
            PG8_WAIT_V(8); PG8_WAIT_L(0); PG8_BAR; PG8_MMA(1, 0, At, B0); PG8_MMA(1, 1, At, B1); PG8_BAR; PG8_SCHED;
        }
        if (wr == 0) PG8_BAR;
        bool keep; if constexpr (G::PRE) keep = g.epi(acc, cur, wr, wc, fr, fq, ui & 1); else keep = g.epi(acc, cur, wr, wc, fr, fq);
        if (!has_next) break;
        if constexpr (G::PRE) g.binit(acc, lds, wid, fq, (ui + 1) & 1);
        else if (!keep)
#pragma unroll
        for (int a = 0; a < 2; ++a)
#pragma unroll
            for (int b = 0; b < 2; ++b)
#pragma unroll
                for (int m = 0; m < 4; ++m)
#pragma unroll
                    for (int n = 0; n < 2; ++n) acc[a][b][m][n] = (f32x4){0.f, 0.f, 0.f, 0.f};
        cur = nxt; ++ui;
        if constexpr (G::GATHER) { vc0[0] = vn0[0]; vc0[1] = vn0[1]; vc1[0] = vn1[0]; vc1[1] = vn1[1]; }
        if (wr == 1) PG8_BAR;
    }
    PG8_WAIT_V(0);
    PG8_BAR;
#undef PG8_SA
#undef PG8_SB
#undef PG8_STAGE
#undef PG8_LDA
#undef PG8_LDB
#undef PG8_MMA
#undef PG8_WAIT_V
#undef PG8_WAIT_L
#undef PG8_BAR
#undef PG8_SCHED
}

struct GInproj {
    static constexpr bool PERM = true, GATHER = false, PRE = false;
    P p; int l, lda, ldb, K, G, c;
    __device__ __forceinline__ bool next(int i, GUnit& u) const {
        int pm, pn; if (!static_tile(i * G + c, T / 256, 28, pm, pn)) return false;
        u.pm = pm; u.pn = pn; u.e = 0; u.pad = 0;
        u.a0 = (const char*)(p.H1() + (size_t)pm * 256 * D); u.a1 = u.a0 + (size_t)HALF * D * 2;
        u.b0 = (const char*)(p.WinT() + ((size_t)l * 7168 + pn * 256) * D); u.b1 = u.b0 + (size_t)HALF * D * 2; return true; }
    __device__ __forceinline__ bool epi(f32x4 (&acc)[2][2][4][2], const GUnit& u, int wr, int wc, int fr, int fq) const {
        const int row0 = u.pm * 256 + wr * 64 + fr, pn = u.pn;
        if (pn < 12) {
            const bool rope = (pn < 4) && (u.pm < TX / 256);
            const float qs = (pn < 2 || pn == 6 || pn == 7) ? QSCALE : 1.f;
            const int axis = wc & 1, i0 = 8 * (fq & 1); const float sg = (fq >> 1) ? 1.f : -1.f;
#pragma unroll
            for (int ai = 0; ai < 2; ++ai) {
                f32x4 tc[4][4];
                if (rope) {
#pragma unroll
                    for (int m = 0; m < 4; ++m) { const int s_ = (row0 + ai * HALF + m * 16) & (SEQ - 1); const float* ct = p.ROPE() + s_ * 32 + axis * 16 + i0; const float* st = ct + SEQ * 32;
                        tc[m][0] = *(const f32x4*)ct; tc[m][1] = *(const f32x4*)(ct + 4); tc[m][2] = *(const f32x4*)st; tc[m][3] = *(const f32x4*)(st + 4); } }
#pragma unroll
                for (int m = 0; m < 4; ++m) { const int row = row0 + ai * HALF + m * 16;
#pragma unroll
                    for (int bj = 0; bj < 2; ++bj) { f32x4 v0 = acc[ai][bj][m][0] * qs, v1 = acc[ai][bj][m][1] * qs; const int col0 = pn * 256 + bj * HALF + wc * 32 + 8 * fq;
                        if (rope) { f32x4 q0, q1;
#pragma unroll
                            for (int j = 0; j < 4; ++j) { q0[j] = __shfl_xor(v0[j], 32); q1[j] = __shfl_xor(v1[j], 32); }
                            v0 = v0 * tc[m][0] + sg * (q0 * tc[m][2]); v1 = v1 * tc[m][1] + sg * (q1 * tc[m][3]); }
                        u32x4 w; w.x = cvt_pk_bf16(v0[0], v0[1]); w.y = cvt_pk_bf16(v0[2], v0[3]); w.z = cvt_pk_bf16(v1[0], v1[1]); w.w = cvt_pk_bf16(v1[2], v1[3]);
                        *(u32x4*)(p.QKV() + (size_t)row * 3072 + col0) = w; } } }
        } else if (pn < 16) {
            LAS bf16_t* stg = (LAS bf16_t*)((LAS unsigned char*)dyn_smem + LDS_SCRATCH) + (wr * 4 + wc) * 1024;
            const int lane = fq * 16 + fr; const bool isx = u.pm < TX / 256;
            const int wofs = ((4 * fq) * 8 + (fr & 7)) * 8 + (fr >> 3);
#pragma unroll
            for (int ai = 0; ai < 2; ++ai) {
                const int rowb = u.pm * 256 + ai * HALF + wr * 64;
                bf16_t* dbase; size_t cst;
                if (isx) { dbase = p.FtX() + ((size_t)(rowb >> 11) * 512 * 8 + (lane & 7)) * 512 + ((rowb & (SEQ - 1)) >> 3); cst = 8 * 512; }
                else { dbase = p.FtY() + (size_t)((rowb - TX) >> 8) * 512 * 512 + (lane & 7) * 32 + (((rowb - TX) & (CTX - 1)) >> 3); cst = 512; }
#pragma unroll
                for (int bj = 0; bj < 2; ++bj)
#pragma unroll
                    for (int n = 0; n < 2; ++n) {
#pragma unroll
                        for (int m = 0; m < 4; ++m)
#pragma unroll
                            for (int j = 0; j < 4; ++j) stg[wofs + 64 * j + 2 * m] = f2bf(acc[ai][bj][m][n][j]);
                        __builtin_amdgcn_s_waitcnt(0xc07f);
#pragma unroll
                        for (int h2 = 0; h2 < 2; ++h2) { const int c16 = (lane >> 3) + 8 * h2;
                            const u32x4 v = *(const LAS u32x4*)(stg + (lane + 64 * h2) * 8);
                            const int cabs = (pn - 12) * 256 + bj * HALF + wc * 32 + 8 * (c16 >> 2) + 4 * n + (c16 & 3);
                            *(u32x4*)(dbase + (size_t)(cabs & 511) * cst + (cabs >> 9) * 256) = v; }
                        __builtin_amdgcn_s_waitcnt(0xc07f);
                    } }
        } else {
#pragma unroll
            for (int ai = 0; ai < 2; ++ai)
#pragma unroll
                for (int m = 0; m < 4; ++m) { const int row = row0 + ai * HALF + m * 16;
#pragma unroll
                    for (int bj = 0; bj < 2; ++bj) { const f32x4 v0 = acc[ai][bj][m][0], v1 = acc[ai][bj][m][1]; const int col0 = (pn - 16) * 256 + bj * HALF + wc * 32 + 8 * fq;
                        uint2 w; w.x = sig255_(v0[0]) | (sig255_(v0[1]) << 8) | (sig255_(v0[2]) << 16) | (sig255_(v0[3]) << 24); w.y = sig255_(v1[0]) | (sig255_(v1[1]) << 8) | (sig255_(v1[2]) << 16) | (sig255_(v1[3]) << 24);
                        *(uint2*)(p.G() + (size_t)row * 3072 + col0) = w; } }
        }
        return false;
    }
};
struct GFourX {
    static constexpr bool PERM = true, GATHER = false, PRE = false;
    P p; int lda, ldb, K, unit, pad0, pad1;
    __device__ __forceinline__ bool next(int i, GUnit& u) const {
        if (i > 0) return false; const int L = unit;
        const int b = L >> 5, t = (L >> 4) & 1, pn = L & 15; u.pm = t; u.pn = pn; u.e = b; u.pad = 0;
        u.a0 = (const char*)(p.CSX() + (size_t)t * 256 * 512); u.a1 = u.a0 + (size_t)HALF * 512 * 2;
        u.b0 = (const char*)(p.FtX() + ((size_t)b * 4096 + pn * 256) * 512); u.b1 = u.b0 + (size_t)HALF * 512 * 2; return true; }
    __device__ __forceinline__ bool epi(f32x4 (&acc)[2][2][4][2], const GUnit& u, int wr, int wc, int fr, int fq) const {
        const float RS = 0.70710678118654752f;
#pragma unroll
        for (int m = 0; m < 4; ++m) { const int k2 = 128 * u.pm + wr * 64 + m * 16 + fr;
            float cw, sw; { const float a = (float)k2 * (1.f / 1024.f); cw = cospif(a); sw = sinpif(a); }
#pragma unroll
            for (int bj = 0; bj < 2; ++bj) { const int col = 32 * u.pn + 16 * bj + 4 * wc + fq;
                float yr[8], yi[8]; float tc = 1.f, ts = 0.f;
#pragma unroll
                for (int q = 0; q < 8; ++q) { const float re = acc[0][bj][m][q >> 2][q & 3], im = acc[1][bj][m][q >> 2][q & 3];
                    yr[q] = re * tc - im * ts; yi[q] = re * ts + im * tc; const float nc = tc * cw - ts * sw; ts = tc * sw + ts * cw; tc = nc; }
                const float a0 = yr[0] + yr[4], a1 = yr[0] - yr[4], b0 = yr[2] + yr[6], b1 = yr[2] - yr[6], c0 = yr[1] + yr[5], c1 = yr[1] - yr[5], d0 = yr[3] + yr[7], d1 = yr[3] - yr[7];
                const float e1 = yi[0] - yi[4], f0 = yi[2] + yi[6], f1 = yi[2] - yi[6], g0 = yi[1] + yi[5], g1 = yi[1] - yi[5], h0 = yi[3] + yi[7], h1 = yi[3] - yi[7];
                (void)e1; (void)f0; (void)g0; (void)h0;
                float o[8];
                o[0] = (a0 + b0) + (c0 + d0);
                o[4] = (a0 + b0) - (c0 + d0);
                o[2] = (a0 - b0) - (g0 - h0);
                o[6] = (a0 - b0) + (g0 - h0);
                o[1] = a1 + RS * (c1 - d1) - (f1 + RS * (g1 + h1));
                o[7] = a1 + RS * (c1 - d1) + (f1 + RS * (g1 + h1));
                o[3] = a1 - RS * (c1 - d1) - (RS * (g1 + h1) - f1);
                o[5] = a1 - RS * (c1 - d1) + (RS * (g1 + h1) - f1);
                bf16_t* dst = p.O() + ((size_t)u.e * SEQ + k2) * 1536 + 1024 + col;
#pragma unroll
                for (int k1 = 0; k1 < 8; ++k1) dst[(size_t)k1 * 256 * 1536] = f2bf(o[k1] * (1.f / 512.f)); } }
        return false;
    }
};
struct GFourY {
    static constexpr bool PERM = true, GATHER = false, PRE = false;
    P p; int lda, ldb, K, unit, pad0, pad1;
    __device__ __forceinline__ bool next(int i, GUnit& u) const {
        if (i > 0) return false; const int L = unit;
        const int b = L >> 1, pn = L & 1; u.pm = 0; u.pn = pn; u.e = b; u.pad = 0;
        u.a0 = (const char*)p.CSY(); u.a1 = u.a0 + (size_t)HALF * 512 * 2;
        u.b0 = (const char*)(p.FtY() + ((size_t)b * 512 + pn * 256) * 512); u.b1 = u.b0 + (size_t)HALF * 512 * 2; return true; }
    __device__ __forceinline__ bool epi(f32x4 (&acc)[2][2][4][2], const GUnit& u, int wr, int wc, int fr, int fq) const {
        const int row0 = TX + u.e * CTX + wr * 64 + fr;
#pragma unroll
        for (int ai = 0; ai < 2; ++ai)
#pragma unroll
            for (int m = 0; m < 4; ++m) { const int row = row0 + ai * HALF + m * 16;
#pragma unroll
                for (int bj = 0; bj < 2; ++bj) { const f32x4 v0 = acc[ai][bj][m][0] * 0.005524271728f, v1 = acc[ai][bj][m][1] * 0.005524271728f; const int col0 = 1024 + u.pn * 256 + bj * HALF + wc * 32 + 8 * fq;
                    u32x4 w; w.x = cvt_pk_bf16(v0[0], v0[1]); w.y = cvt_pk_bf16(v0[2], v0[3]); w.z = cvt_pk_bf16(v1[0], v1[1]); w.w = cvt_pk_bf16(v1[2], v1[3]);
                    *(u32x4*)(p.O() + (size_t)row * 1536 + col0) = w; } }
        return false;
    }
};
struct GMerge {
    static constexpr bool PERM = true, GATHER = false, PRE = false;
    P p; int l, nM, lda, ldb, K, G, c, ytile;
    __device__ __forceinline__ bool next(int i, GUnit& u) const {
        const int ti = i / 3, br = i - ti * 3; int pm, pn;
        if (ytile >= 0) { if (ti > 0) return false; pm = 64 + (ytile >> 2); pn = ytile & 3; }
        else if (!static_tile(ti * G + c, nM, 4, pm, pn)) return false;
        u.pm = pm; u.pn = pn; u.e = br; u.pad = 0;
        u.a0 = (const char*)(p.O() + (size_t)pm * 256 * 1536 + br * 512); u.a1 = u.a0 + (size_t)HALF * 1536 * 2;
        u.b0 = (const char*)(p.WbT() + (((size_t)l * 3 + br) * D + pn * 256) * 512); u.b1 = u.b0 + (size_t)HALF * 512 * 2; return true; }
    __device__ __forceinline__ bool epi(f32x4 (&acc)[2][2][4][2], const GUnit& u, int wr, int wc, int fr, int fq) const {
        const int row0 = u.pm * 256 + wr * 64 + fr, br = u.e, colb = u.pn * 256 + wc * 32 + 8 * fq;
#pragma unroll
        for (int ai = 0; ai < 2; ++ai) {
            uint2 ga[4][2], gb[4][2];
#pragma unroll
            for (int m = 0; m < 4; ++m)
#pragma unroll
                for (int bj = 0; bj < 2; ++bj) { const unsigned char* gp = p.G() + (size_t)(row0 + ai * HALF + m * 16) * 3072 + br * D + colb + bj * HALF;
                    ga[m][bj] = *(const uint2*)gp; if (br < 2) gb[m][bj] = *(const uint2*)(gp + D); }
#pragma unroll
            for (int m = 0; m < 4; ++m)
#pragma unroll
                for (int bj = 0; bj < 2; ++bj) { float f[8];
#pragma unroll
                    for (int q = 0; q < 4; ++q) { f[q] = __builtin_fmaf((float)((ga[m][bj].x >> (8 * q)) & 0xffu), 1.f / 255.f, 0.5f / 255.f); f[4 + q] = __builtin_fmaf((float)((ga[m][bj].y >> (8 * q)) & 0xffu), 1.f / 255.f, 0.5f / 255.f); }
                    if (br < 2) {
#pragma unroll
                        for (int q = 0; q < 4; ++q) {
                            f[q] *= __builtin_amdgcn_rcpf(__builtin_fmaf((float)((gb[m][bj].x >> (8 * q)) & 0xffu), 1.f / 255.f, 0.5f / 255.f)); f[4 + q] *= __builtin_amdgcn_rcpf(__builtin_fmaf((float)((gb[m][bj].y >> (8 * q)) & 0xffu), 1.f / 255.f, 0.5f / 255.f)); } }
                    f32x4 v0 = acc[ai][bj][m][0], v1 = acc[ai][bj][m][1];
                    v0[0] *= f[0]; v0[1] *= f[1]; v0[2] *= f[2]; v0[3] *= f[3]; v1[0] *= f[4]; v1[1] *= f[5]; v1[2] *= f[6]; v1[3] *= f[7];
                    if (br < 2) { acc[ai][bj][m][0] = v0; acc[ai][bj][m][1] = v1; }
                    else { u32x4 w; w.x = cvt_pk_bf16(v0[0], v0[1]); w.y = cvt_pk_bf16(v0[2], v0[3]); w.z = cvt_pk_bf16(v1[0], v1[1]); w.w = cvt_pk_bf16(v1[2], v1[3]);
                        *(u32x4*)(p.Mg() + (size_t)(row0 + ai * HALF + m * 16) * D + colb + bj * HALF) = w; } } }
        return br < 2;
    }
};
struct GOut {
    static constexpr bool PERM = false, GATHER = false, PRE = false;
    P p; int l, nM, lda, ldb, K, G, c, ytile; float scale; int pad;
    __device__ __forceinline__ bool next(int i, GUnit& u) const {
        int pm, pn;
        if (ytile >= 0) { if (i > 0) return false; pm = 64 + (ytile >> 2); pn = ytile & 3; }
        else if (!static_tile(i * G + c, nM, 4, pm, pn)) return false;
        u.pm = pm; u.pn = pn; u.e = 0; u.pad = 0;
        u.a0 = (const char*)(p.Mg() + (size_t)pm * 256 * D); u.a1 = u.a0 + (size_t)HALF * D * 2;
        u.b0 = (const char*)(p.WoT() + ((size_t)l * D + pn * 256) * D); u.b1 = u.b0 + (size_t)HALF * D * 2; return true; }
    __device__ __forceinline__ bool epi(f32x4 (&acc)[2][2][4][2], const GUnit& u, int wr, int wc, int fr, int fq) const {
        const int row0 = u.pm * 256 + wr * 64 + fr, col0 = u.pn * 256 + wc * 32 + 4 * fq;
        const float* g1 = p.MOD() + (size_t)(l * 9 + modidx(u.pm * 256)) * NMOD + 2 * D;
        f32x4 gv[2][2];
#pragma unroll
        for (int bj = 0; bj < 2; ++bj)
#pragma unroll
            for (int n = 0; n < 2; ++n) gv[bj][n] = *(const f32x4*)(g1 + col0 + bj * HALF + n * 16) * scale;
#pragma unroll
        for (int ai = 0; ai < 2; ++ai) { f32x4 xv[4][2][2];
#pragma unroll
            for (int m = 0; m < 4; ++m)
#pragma unroll
                for (int bj = 0; bj < 2; ++bj)
#pragma unroll
                    for (int n = 0; n < 2; ++n) { const float4 x4 = ldx4(p.X() + (size_t)(row0 + ai * HALF + m * 16) * D + col0 + bj * HALF + n * 16); xv[m][bj][n] = (f32x4){x4.x, x4.y, x4.z, x4.w}; }
#pragma unroll
            for (int m = 0; m < 4; ++m)
#pragma unroll
                for (int bj = 0; bj < 2; ++bj)
#pragma unroll
                    for (int n = 0; n < 2; ++n) { const f32x4 r = xv[m][bj][n] + gv[bj][n] * acc[ai][bj][m][n]; uint2 w; w.x = cvt_pk_bf16(r[0], r[1]); w.y = cvt_pk_bf16(r[2], r[3]);
                        *(uint2*)(p.X() + (size_t)(row0 + ai * HALF + m * 16) * D + col0 + bj * HALF + n * 16) = w; } }
        return false;
    }
};
__device__ __forceinline__ void moe_tiles(const P& p, int l, LAS int* mtb) {
    const int t_ = otid();
    if (t_ < 64) { const int t = t_; int v = t < NEXP ? (p.CNT()[l * NEXP + t] + 255) >> 8 : 0;
        for (int o = 1; o < 32; o <<= 1) { const int u = __shfl_up(v, o); if ((t & 63) >= o) v += u; }
        if (t < NEXP) mtb[t + 1] = v; if (t == 0) mtb[0] = 0; if (t < NEXP) mtb[40 + t] = p.CNT()[l * NEXP + t]; }
    __syncthreads();
}
template <int NN>
__device__ __forceinline__ bool moe_unit(const LAS int* mtb, int i, int G, int c, int& e, int& rowbase, int& pn) {
    const int total = mtb[NEXP] * NN;
    const int L = i * G + c; if (L >= total) return false;
    const int mt = L / NN; pn = L - mt * NN; int ee = 0; while (ee < NEXP - 1 && mtb[ee + 1] <= mt) ++ee;
    e = ee; rowbase = ee * CAP + (mt - mtb[ee]) * 256; return true;
}
struct GGateUp {
    static constexpr bool PERM = true, GATHER = true, PRE = true;
    P p; const LAS int* mtb; int l, lda, ldb, K, G, c, cheap, pad;
    __device__ __forceinline__ bool next(int i, GUnit& u) const {
        int e, rb, pn; if (!moe_unit<8>(mtb, i, G, c, e, rb, pn)) return false;
        u.pm = rb; u.pn = pn; u.e = e; u.pad = mtb[40 + e] - (rb - e * CAP);
        u.a0 = (const char*)p.H1(); u.a1 = u.a0;
        const bf16_t* w = p.WguT() + ((size_t)l * NEXP + e) * 2048 * D; u.b0 = (const char*)(w + (size_t)pn * 128 * D); u.b1 = (const char*)(w + (size_t)(1024 + pn * 128) * D); return true; }
    __device__ __forceinline__ void gather(const GUnit& u, const int (&R)[2], const int (&C2)[2], unsigned (&v0)[2], unsigned (&v1)[2]) const {
        const int* li = p.LIST() + u.pm;
#pragma unroll
        for (int i = 0; i < 2; ++i) { const int t0 = (R[i] < u.pad) ? li[R[i]] : 0, t1 = (R[i] + HALF < u.pad) ? li[R[i] + HALF] : 0;
            v0[i] = (unsigned)t0 * (unsigned)(D * 2) + (unsigned)C2[i]; v1[i] = (unsigned)t1 * (unsigned)(D * 2) + (unsigned)C2[i]; } }
    __device__ __forceinline__ void pre(const GUnit& u, LAS unsigned char* lds, int wid, int lane, int sl) const {
        const float* src = p.b_gu + ((size_t)l * NEXP + u.e) * 2048 + u.pn * 128 + (wid & 3) * 32 + (lane & 31) + (lane >> 5) * 1024;
        __builtin_amdgcn_global_load_lds((const unsigned*)src, (LAS unsigned*)(lds + LDS_SCRATCH + 512 + sl * PRE_SLOT + wid * 768), 4, 0, 0); }
    __device__ __forceinline__ void binit(f32x4 (&acc)[2][2][4][2], LAS unsigned char* lds, int wid, int fq, int sl) const {
        const LAS float* bb = (const LAS float*)(lds + LDS_SCRATCH + 512 + sl * PRE_SLOT + wid * 768) + 8 * fq;
        f32x4 bg[2], bu[2];
#pragma unroll
        for (int n = 0; n < 2; ++n) { bg[n] = *(const LAS f32x4*)(bb + 4 * n); bu[n] = *(const LAS f32x4*)(bb + 32 + 4 * n); }
#pragma unroll
        for (int ai = 0; ai < 2; ++ai)
#pragma unroll
            for (int m = 0; m < 4; ++m)
#pragma unroll
                for (int n = 0; n < 2; ++n) { acc[ai][0][m][n] = bg[n]; acc[ai][1][m][n] = bu[n]; } }
    __device__ __forceinline__ bool epi(f32x4 (&acc)[2][2][4][2], const GUnit& u, int wr, int wc, int fr, int fq, int sl) const {
        if (cheap) {
#pragma unroll
            for (int a = 0; a < 2; ++a)
#pragma unroll
                for (int b = 0; b < 2; ++b)
#pragma unroll
                    for (int m = 0; m < 4; ++m)
#pragma unroll
                        for (int n = 0; n < 2; ++n) asm volatile("" :: "v"(acc[a][b][m][n]));
            return false; }
        const int row0 = u.pm + wr * 64 + fr, j0 = u.pn * 128 + wc * 32 + 8 * fq;
#pragma unroll
        for (int ai = 0; ai < 2; ++ai)
#pragma unroll
            for (int m = 0; m < 4; ++m) { const int row = row0 + ai * HALF + m * 16; float a[8];
#pragma unroll
                for (int n = 0; n < 2; ++n)
#pragma unroll
                    for (int j = 0; j < 4; ++j) { const float gate = fminf(acc[ai][0][m][n][j], 7.f), up = __builtin_amdgcn_fmed3f(acc[ai][1][m][n][j], -7.f, 7.f);
                        const float t = gate * __builtin_amdgcn_rcpf(1.f + __builtin_amdgcn_exp2f(gate * (-1.702f * 1.4426950408889634f))); a[4 * n + j] = __builtin_fmaf(up, t, t); }
                u32x4 w; w.x = cvt_pk_bf16(a[0], a[1]); w.y = cvt_pk_bf16(a[2], a[3]); w.z = cvt_pk_bf16(a[4], a[5]); w.w = cvt_pk_bf16(a[6], a[7]);
                *(u32x4*)(p.ACT() + (size_t)row * D + j0) = w; }
        return false;
    }
};
struct GDown {
    static constexpr bool PERM = true, GATHER = false, PRE = true;
    P p; const LAS int* mtb; int l, lda, ldb, K, G, c;
    __device__ __forceinline__ bool next(int i, GUnit& u) const {
        int e, rb, pn; if (!moe_unit<4>(mtb, i, G, c, e, rb, pn)) return false;
        u.pm = rb; u.pn = pn; u.e = e; u.pad = 0;
        u.a0 = (const char*)(p.ACT() + (size_t)rb * D); u.a1 = u.a0 + (size_t)HALF * D * 2;
        u.b0 = (const char*)(p.WdT() + (((size_t)l * NEXP + e) * D + pn * 256) * D); u.b1 = u.b0 + (size_t)HALF * D * 2; return true; }
    __device__ __forceinline__ void pre(const GUnit& u, LAS unsigned char* lds, int wid, int lane, int slt) const {
        LAS unsigned char* sl = lds + LDS_SCRATCH + 512 + slt * PRE_SLOT + wid * 768;
        const float* bs = p.b_dn + ((size_t)l * NEXP + u.e) * D + u.pn * 256 + (wid & 3) * 32 + (lane & 31) + (lane >> 5) * HALF;
        const float* rs = p.SROWW() + u.pm + (wid >> 2) * 64 + lane;
        __builtin_amdgcn_global_load_lds((const unsigned*)bs, (LAS unsigned*)sl, 4, 0, 0);
        __builtin_amdgcn_global_load_lds((const unsigned*)rs, (LAS unsigned*)(sl + 256), 4, 0, 0);
        __builtin_amdgcn_global_load_lds((const unsigned*)(rs + HALF), (LAS unsigned*)(sl + 512), 4, 0, 0); }
    __device__ __forceinline__ void binit(f32x4 (&acc)[2][2][4][2], LAS unsigned char* lds, int wid, int fq, int slt) const {
        const LAS float* sl = (const LAS float*)(lds + LDS_SCRATCH + 512 + slt * PRE_SLOT + wid * 768);
#pragma unroll
        for (int bj = 0; bj < 2; ++bj)
#pragma unroll
            for (int n = 0; n < 2; ++n) { const f32x4 b = *(const LAS f32x4*)(sl + bj * 32 + 8 * fq + 4 * n);
#pragma unroll
                for (int ai = 0; ai < 2; ++ai)
#pragma unroll
                    for (int m = 0; m < 4; ++m) acc[ai][bj][m][n] = b; } }
    __device__ __forceinline__ bool epi(f32x4 (&acc)[2][2][4][2], const GUnit& u, int wr, int wc, int fr, int fq, int slt) const {
        const int row0 = u.pm + wr * 64 + fr, colb = u.pn * 256 + wc * 32 + 8 * fq;
        const LAS float* sl = (const LAS float*)((const LAS unsigned char*)dyn_smem + LDS_SCRATCH + 512 + slt * PRE_SLOT + (wr * 4 + wc) * 768);
        float rws[2][4];
#pragma unroll
        for (int ai = 0; ai < 2; ++ai)
#pragma unroll
            for (int m = 0; m < 4; ++m) rws[ai][m] = sl[64 + ai * 64 + m * 16 + fr];
#pragma unroll
        for (int ai = 0; ai < 2; ++ai)
#pragma unroll
            for (int m = 0; m < 4; ++m) { const int row = row0 + ai * HALF + m * 16; const float rw = rws[ai][m];
#pragma unroll
                for (int bj = 0; bj < 2; ++bj) { const f32x4 v0 = acc[ai][bj][m][0] * rw, v1 = acc[ai][bj][m][1] * rw;
                    u32x4 w; w.x = cvt_pk_bf16(v0[0], v0[1]); w.y = cvt_pk_bf16(v0[2], v0[3]); w.z = cvt_pk_bf16(v1[0], v1[1]); w.w = cvt_pk_bf16(v1[2], v1[3]);
                    *(u32x4*)(p.YS() + (size_t)row * D + colb + bj * HALF) = w; } }
        return false;
    }
};
typedef float f32x16 __attribute__((ext_vector_type(16)));
typedef short s16x4 __attribute__((ext_vector_type(4)));
__device__ __forceinline__ int crow(int r, int hi) { return (r & 3) + 8 * (r >> 2) + 4 * hi; }
__device__ __forceinline__ s16x4 vtr(const LAS unsigned char* q) { return __builtin_bit_cast(s16x4, __builtin_amdgcn_ds_read_tr16_b64_v4i16((LAS s16x4*)q)); }
constexpr int AT_WSF = 139264, AT_TAB = AT_WSF + 2048, AT_X1 = 73728;
template <int MODE>
__device__ __forceinline__ void attn_unit_seq(const P& p, int l, LAS unsigned char* lds, int h, int qrow0, int kb0, int n0, int kb1, int n1, int R0, int j0) {
    constexpr int DV = MODE == 0 ? 128 : 64, ND = DV / 32, KB = MODE == 0 ? 16384 : 8192, VB = DV * 64 * 2, SLOT = KB + VB;
    const int tid = otid(), lane = tid & 63, r32 = lane & 31, hi = lane >> 5, wid = __builtin_amdgcn_readfirstlane(tid >> 6);
    const int msub = MODE == 0 ? (wid >> 2) : 0;
    const int qbase = qrow0 + (MODE == 0 ? 32 * (wid & 3) : 32 * wid);
    const int qcol = MODE == 0 ? h * 128 + msub * 64 : 1536 + h * 64;
    const int kcol = MODE == 0 ? 512 + h * 128 : 2048 + h * 64;
    const int vcol = MODE == 0 ? 1024 + h * 128 : 2560 + h * 64;
    const int rp = wid >> 2, g = wid & 3, ks0 = min(max(16 * g - 8, 0), 32);
    int qtok = qbase + r32, rq = 0, rs_q = 0, qc = 0, cs = 0, rsA = 0, rsB = 0;
    if (MODE == 1) { rq = R0 + 2 * rp + (r32 >> 4); qc = 16 * g + (r32 & 15); qtok = qrow0 + (2 * rp + (r32 >> 4)) * 64 + qc;
        rs_q = min(max(rq - 4, 0), 24); cs = min(max(qc - 8, 0), 48); rsA = min(max(R0 + 2 * rp - 4, 0), 24); rsB = min(max(R0 + 2 * rp - 3, 0), 24); }
    bf16x8 qr[4];
#pragma unroll
    for (int d0 = 0; d0 < 4; ++d0) qr[d0] = *(const bf16x8*)(p.QKV() + (size_t)qtok * 3072 + qcol + d0 * 16 + hi * 8);
    LAS float* wsf = (LAS float*)(lds + AT_WSF + wid * 256);
    LAS float* tab = (LAS float*)(lds + AT_TAB);
    if (MODE == 1) { for (int i = tid; i < 768; i += 512) { const int idx = i - 64; float v = 0.f;
            if (idx >= 0 && idx < 480) { const int dr = idx >> 5, dc = idx & 31; if (dc < 31) v = p.na_rpb[((size_t)(l * 8 + h) * 15 + dr) * 31 + dc] * 1.4426950408889634f; }
            tab[i] = v; } }
    const int NT = n0 + n1;
    auto issueK = [&](int t, int s) {
        const int tb = t < n0 ? kb0 + 64 * t : kb1 + 64 * (t - n0); LAS unsigned char* slot = lds + s * KB;
        if (MODE == 0) {
#pragma unroll
            for (int i = 0; i < 2; ++i) { const int id = wid * 2 + i;
                __builtin_amdgcn_global_load_lds((const unsigned*)(p.QKV() + (size_t)(tb + 8 * (id & 7) + (lane & 7)) * 3072 + kcol + (id >> 3) * 64 + ((lane >> 3) ^ (id & 1)) * 8), (LAS unsigned*)(slot + (id >> 3) * 8192 + (id & 7) * 1024), 16, 0, 0); }
        } else __builtin_amdgcn_global_load_lds((const unsigned*)(p.QKV() + (size_t)(tb + 8 * wid + (lane & 7)) * 3072 + kcol + ((lane >> 3) ^ (wid & 1)) * 8), (LAS unsigned*)(slot + wid * 1024), 16, 0, 0);
    };
    auto issueV = [&](int t, int s) {
        const int tb = t < n0 ? kb0 + 64 * t : kb1 + 64 * (t - n0); LAS unsigned char* slot = lds + 2 * KB + s * VB;
        if (MODE == 0) {
#pragma unroll
            for (int i = 0; i < 2; ++i) { const int id = wid * 2 + i;
                __builtin_amdgcn_global_load_lds((const unsigned*)(p.QKV() + (size_t)(tb + 16 * (id & 3) + (lane >> 2)) * 3072 + vcol + 32 * (id >> 2) + (lane & 3) * 8), (LAS unsigned*)(slot + (id >> 2) * 4096 + (id & 3) * 1024), 16, 0, 0); }
        } else __builtin_amdgcn_global_load_lds((const unsigned*)(p.QKV() + (size_t)(tb + 16 * (wid & 3) + (lane >> 2)) * 3072 + vcol + 32 * (wid >> 2) + (lane & 3) * 8), (LAS unsigned*)(slot + (wid >> 2) * 4096 + (wid & 3) * 1024), 16, 0, 0);
    };
    auto tile_act = [&](int t) -> bool { if (MODE != 1 || t >= n0) return true; const int j = j0 + t; return (j >= rsA) && (j < rsB + 8); };
    auto qk = [&](int t, f32x16& a0, f32x16& a1, float init) {
        if (MODE == 1 && t < n0) {
            const int kb_ = (ks0 + r32) >> 3; const LAS unsigned char* kp = lds + (t & 1) * KB + kb_ * 1024 + (r32 & 7) * 16 + ((hi ^ (kb_ & 1)) * 128);
#pragma unroll
            for (int r = 0; r < 16; ++r) a0[r] = init;
#pragma unroll
            for (int d0 = 0; d0 < 4; ++d0) { const bf16x8 b0 = *(const LAS bf16x8*)(kp + d0 * 256); a0 = __builtin_amdgcn_mfma_f32_32x32x16_bf16(b0, qr[d0], a0, 0, 0, 0); }
        } else {
            const LAS unsigned char* kp = lds + (t & 1) * KB + msub * 8192 + (r32 >> 3) * 1024 + (r32 & 7) * 16 + ((hi ^ ((r32 >> 3) & 1)) * 128);
#pragma unroll
            for (int r = 0; r < 16; ++r) { a0[r] = init; a1[r] = init; }
#pragma unroll
            for (int d0 = 0; d0 < 4; ++d0) { const bf16x8 b0 = *(const LAS bf16x8*)(kp + d0 * 256), b1 = *(const LAS bf16x8*)(kp + d0 * 256 + 4096);
                a0 = __builtin_amdgcn_mfma_f32_32x32x16_bf16(b0, qr[d0], a0, 0, 0, 0); a1 = __builtin_amdgcn_mfma_f32_32x32x16_bf16(b1, qr[d0], a1, 0, 0, 0); }
        }
    };
    f32x16 o[ND];
#pragma unroll
    for (int d0 = 0; d0 < ND; ++d0)
#pragma unroll
        for (int r = 0; r < 16; ++r) o[d0][r] = 0.f;
    float mref = 0.f;
    f32x16 osum;
#pragma unroll
    for (int r = 0; r < 16; ++r) osum[r] = 0.f;
    const bf16x8 ones = (bf16x8){16256, 16256, 16256, 16256, 16256, 16256, 16256, 16256};
    f32x16 pa0, pa1, pb0, pb1;
#pragma unroll
    for (int r = 0; r < 16; ++r) { pa1[r] = 0.f; pb1[r] = 0.f; }
    issueK(0, 0); issueV(0, 0); if (NT > 1) issueK(1, 1);
    asm volatile("s_waitcnt vmcnt(0)" ::: "memory");
    __syncthreads();
    if (tile_act(0)) qk(0, pa0, pa1, 0.f);
    __syncthreads();
    auto step = [&](int t, f32x16& c0, f32x16& c1, f32x16& x0, f32x16& x1) {
        if (t + 2 < NT) issueK(t + 2, t & 1);
        if (t + 1 < NT) issueV(t + 1, (t + 1) & 1);
        const bool act = tile_act(t), actn = (t + 1 < NT) && tile_act(t + 1);
        if (actn) qk(t + 1, x0, x1, -mref);
        if (act) {
            const bool nb = (MODE == 1) && (t < n0);
            float rm;
            if (nb) { const int j = j0 + t, dr = j - rq + 7; const bool rowact = (j >= rs_q) && (j < rs_q + 8);
                const LAS float* tb_ = tab + 64 + dr * 32 + (ks0 + 4 * hi - qc + 15); const int kbase = rowact ? (ks0 + 4 * hi - cs) : 1000;
#pragma unroll
                for (int r = 0; r < 16; ++r) { const int ko = (r & 3) + 8 * (r >> 2); c0[r] = ((unsigned)(kbase + ko) < 16u) ? c0[r] + tb_[ko] : -1e30f; }
                float ra = __builtin_fmaxf(__builtin_fmaxf(c0[0], c0[1]), c0[2]), rb = __builtin_fmaxf(__builtin_fmaxf(c0[3], c0[4]), c0[5]);
                ra = __builtin_fmaxf(__builtin_fmaxf(ra, c0[6]), c0[7]); rb = __builtin_fmaxf(__builtin_fmaxf(rb, c0[8]), c0[9]);
                ra = __builtin_fmaxf(__builtin_fmaxf(ra, c0[10]), c0[11]); rb = __builtin_fmaxf(__builtin_fmaxf(rb, c0[12]), c0[13]);
                rm = __builtin_fmaxf(__builtin_fmaxf(ra, rb), __builtin_fmaxf(c0[14], c0[15]));
            } else {
                float ra = __builtin_fmaxf(__builtin_fmaxf(c0[0], c0[1]), c1[0]), rb = __builtin_fmaxf(__builtin_fmaxf(c0[2], c0[3]), c1[1]);
                ra = __builtin_fmaxf(__builtin_fmaxf(ra, c1[2]), c1[3]);
#pragma unroll
                for (int r = 4; r < 16; r += 4) { ra = __builtin_fmaxf(__builtin_fmaxf(ra, c0[r]), c0[r + 1]); rb = __builtin_fmaxf(__builtin_fmaxf(rb, c0[r + 2]), c0[r + 3]);
                    ra = __builtin_fmaxf(__builtin_fmaxf(ra, c1[r]), c1[r + 1]); rb = __builtin_fmaxf(__builtin_fmaxf(rb, c1[r + 2]), c1[r + 3]); }
                rm = __builtin_fmaxf(ra, rb);
            }
            rm = __builtin_fmaxf(rm, __shfl_xor(rm, 32));
            const bool mv = (rm > 8.f) || (rm < -40.f && rm > -1e29f);
            if (__any(mv)) {
                const float dl = mv ? rm : 0.f; mref += dl; const float f = __builtin_amdgcn_exp2f(-dl);
#pragma unroll
                for (int r = 0; r < 16; ++r) { c0[r] -= dl; c1[r] -= dl; }
                if (actn) {
#pragma unroll
                    for (int r = 0; r < 16; ++r) { x0[r] -= dl; x1[r] -= dl; } }
                if (hi == 0) wsf[r32] = f;
                __builtin_amdgcn_s_waitcnt(0xc07f);
#pragma unroll
                for (int r = 0; r < 16; ++r) { const float fr_ = wsf[crow(r, hi)]; osum[r] *= fr_;
#pragma unroll
                    for (int d0 = 0; d0 < ND; ++d0) o[d0][r] *= fr_; }
            }
            const LAS unsigned char* vp = lds + 2 * KB + (t & 1) * VB + ((lane >> 4) & 1) * 32 + (lane & 3) * 8 + (4 * hi + ((lane & 15) >> 2)) * 64;
            if (nb) {
#pragma unroll
                for (int r = 0; r < 16; ++r) c0[r] = __builtin_amdgcn_exp2f(c0[r]);
                u32x4 pw[2];
#pragma unroll
                for (int k = 0; k < 2; ++k) pw[k] = (u32x4){cvt_pk_bf16(c0[8 * k], c0[8 * k + 1]), cvt_pk_bf16(c0[8 * k + 2], c0[8 * k + 3]), cvt_pk_bf16(c0[8 * k + 4], c0[8 * k + 5]), cvt_pk_bf16(c0[8 * k + 6], c0[8 * k + 7])};
#pragma unroll
                for (int ks = 0; ks < 2; ++ks) osum = __builtin_amdgcn_mfma_f32_32x32x16_bf16(__builtin_bit_cast(bf16x8, pw[ks]), ones, osum, 0, 0, 0);
#pragma unroll
                for (int d0 = 0; d0 < ND; ++d0)
#pragma unroll
                    for (int ks = 0; ks < 2; ++ks) { const int ka = ks0 + 16 * ks, kb_ = ka + 8;
                        const s16x4 lo = vtr(vp + d0 * 4096 + (ka >> 4) * 1024 + ((ka >> 3) & 1) * 512), hh = vtr(vp + d0 * 4096 + (kb_ >> 4) * 1024 + ((kb_ >> 3) & 1) * 512);
                        const bf16x8 vf = (bf16x8){lo[0], lo[1], lo[2], lo[3], hh[0], hh[1], hh[2], hh[3]};
                        o[d0] = __builtin_amdgcn_mfma_f32_32x32x16_bf16(__builtin_bit_cast(bf16x8, pw[ks]), vf, o[d0], 0, 0, 0); }
            } else {
#pragma unroll
                for (int r = 0; r < 16; ++r) { c0[r] = __builtin_amdgcn_exp2f(c0[r]); c1[r] = __builtin_amdgcn_exp2f(c1[r]); }
                u32x4 pw[4];
#pragma unroll
                for (int k = 0; k < 2; ++k) {
                    pw[k] = (u32x4){cvt_pk_bf16(c0[8 * k], c0[8 * k + 1]), cvt_pk_bf16(c0[8 * k + 2], c0[8 * k + 3]), cvt_pk_bf16(c0[8 * k + 4], c0[8 * k + 5]), cvt_pk_bf16(c0[8 * k + 6], c0[8 * k + 7])};
                    pw[2 + k] = (u32x4){cvt_pk_bf16(c1[8 * k], c1[8 * k + 1]), cvt_pk_bf16(c1[8 * k + 2], c1[8 * k + 3]), cvt_pk_bf16(c1[8 * k + 4], c1[8 * k + 5]), cvt_pk_bf16(c1[8 * k + 6], c1[8 * k + 7])}; }
#pragma unroll
                for (int ks = 0; ks < 4; ++ks) osum = __builtin_amdgcn_mfma_f32_32x32x16_bf16(__builtin_bit_cast(bf16x8, pw[ks]), ones, osum, 0, 0, 0);
#pragma unroll
                for (int d0 = 0; d0 < ND; ++d0)
#pragma unroll
                    for (int ks = 0; ks < 4; ++ks) { const s16x4 lo = vtr(vp + d0 * 4096 + ks * 1024), hh = vtr(vp + d0 * 4096 + ks * 1024 + 512);
                        const bf16x8 vf = (bf16x8){lo[0], lo[1], lo[2], lo[3], hh[0], hh[1], hh[2], hh[3]};
                        o[d0] = __builtin_amdgcn_mfma_f32_32x32x16_bf16(__builtin_bit_cast(bf16x8, pw[ks]), vf, o[d0], 0, 0, 0); }
            }
        }
        asm volatile("s_waitcnt vmcnt(0)" ::: "memory");
        __syncthreads();
    };
    for (int t = 0; t < NT; t += 2) {
        step(t, pa0, pa1, pb0, pb1);
        if (t + 1 < NT) step(t + 1, pb0, pb1, pa0, pa1);
    }
    float rl[16];
    { const float lamf = (MODE == 0 && msub == 1) ? p.LAM()[l] : 1.f;
#pragma unroll
      for (int r = 0; r < 16; ++r) rl[r] = lamf * __builtin_amdgcn_rcpf(osum[r]); }
    if (MODE == 0) {
        LAS float* x1 = (LAS float*)(lds + AT_X1) + (wid & 3) * 4096 + lane;
        if (msub == 1) {
#pragma unroll
            for (int d0 = 0; d0 < ND; ++d0)
#pragma unroll
                for (int r = 0; r < 16; ++r) x1[(d0 * 16 + r) * 64] = o[d0][r] * rl[r];
        }
        __syncthreads();
        if (msub == 0) {
            LAS float* st = (LAS float*)(lds + wid * 16896);
#pragma unroll
            for (int d0 = 0; d0 < ND; ++d0)
#pragma unroll
                for (int r = 0; r < 16; ++r) st[crow(r, hi) * 132 + d0 * 32 + r32] = o[d0][r] * rl[r] - x1[(d0 * 16 + r) * 64];
            __builtin_amdgcn_s_waitcnt(0xc07f);
            const int q = lane >> 1, half = lane & 1;
            f32x4 v[16]; float ss = 0.f;
#pragma unroll
            for (int i = 0; i < 16; ++i) { v[i] = *(const LAS f32x4*)(st + q * 132 + half * 64 + i * 4); ss += v[i][0] * v[i][0] + v[i][1] * v[i][1] + v[i][2] * v[i][2] + v[i][3] * v[i][3]; }
            ss += __shfl_xor(ss, 1);
            const float rn = rsqrtf(ss * (1.f / 128.f) + EPS) * (1.f - (0.8f - 0.6f * __expf(-0.3f * (float)l)));
            const float* g = p.da_subln_g + l * 128 + half * 64;
            bf16_t* dst = p.O() + (size_t)(qbase + q) * 1536 + h * 128 + half * 64;
#pragma unroll
            for (int i = 0; i < 8; ++i) { const f32x4 ga = *(const f32x4*)(g + i * 8), gb = *(const f32x4*)(g + i * 8 + 4); const f32x4 a = v[2 * i] * ga * rn, b = v[2 * i + 1] * gb * rn;
                u32x4 w; w.x = cvt_pk_bf16(a[0], a[1]); w.y = cvt_pk_bf16(a[2], a[3]); w.z = cvt_pk_bf16(b[0], b[1]); w.w = cvt_pk_bf16(b[2], b[3]);
                *(u32x4*)(dst + i * 8) = w; }
        }
    } else {
        LAS bf16_t* stg = (LAS bf16_t*)(lds + AT_X1 + wid * 4096);
#pragma unroll
        for (int r = 0; r < 16; ++r)
#pragma unroll
            for (int d0 = 0; d0 < ND; ++d0) stg[crow(r, hi) * 64 + d0 * 32 + r32] = f2bf(o[d0][r] * rl[r]);
        __builtin_amdgcn_s_waitcnt(0xc07f);
#pragma unroll
        for (int i = 0; i < 4; ++i) { const int row = i * 8 + (lane >> 3), ch = lane & 7; const u32x4 v = *(const LAS u32x4*)(stg + row * 64 + ch * 8);
            const int tok = (MODE == 1) ? qrow0 + (2 * rp + (row >> 4)) * 64 + 16 * g + (row & 15) : qbase + row;
            *(u32x4*)(p.O() + (size_t)tok * 1536 + 512 + h * 64 + ch * 8) = v; }
    }
    __syncthreads();
}

template <int MODE>
__device__ __forceinline__ void attn_unit(const P& p, int l, LAS unsigned char* lds, int h, int qrow0, int kb0, int n0, int kb1, int n1, int R0, int j0) {
    constexpr int DV = MODE == 0 ? 128 : 64, ND = DV / 32, KB = MODE == 0 ? 16384 : 8192, VB = DV * 64 * 2, SLOT = KB + VB;
    const int tid = otid(), lane = tid & 63, r32 = lane & 31, hi = lane >> 5, wid = __builtin_amdgcn_readfirstlane(tid >> 6);
    const int msub = MODE == 0 ? (wid >> 2) : 0;
    const int qbase = qrow0 + (MODE == 0 ? 32 * (wid & 3) : 32 * wid);
    const int qcol = MODE == 0 ? h * 128 + msub * 64 : 1536 + h * 64;
    const int kcol = MODE == 0 ? 512 + h * 128 : 2048 + h * 64;
    const int vcol = MODE == 0 ? 1024 + h * 128 : 2560 + h * 64;
    const int rp = wid >> 2, g = wid & 3, ks0 = min(max(16 * g - 8, 0), 32);
    int qtok = qbase + r32, rq = 0, rs_q = 0, qc = 0, cs = 0, rsA = 0, rsB = 0;
    if (MODE == 1) { rq = R0 + 2 * rp + (r32 >> 4); qc = 16 * g + (r32 & 15); qtok = qrow0 + (2 * rp + (r32 >> 4)) * 64 + qc;
        rs_q = min(max(rq - 4, 0), 24); cs = min(max(qc - 8, 0), 48); rsA = min(max(R0 + 2 * rp - 4, 0), 24); rsB = min(max(R0 + 2 * rp - 3, 0), 24); }
    bf16x8 qr[4];
#pragma unroll
    for (int d0 = 0; d0 < 4; ++d0) qr[d0] = *(const bf16x8*)(p.QKV() + (size_t)qtok * 3072 + qcol + d0 * 16 + hi * 8);
    LAS float* wsf = (LAS float*)(lds + AT_WSF + wid * 256);
    LAS float* tab = (LAS float*)(lds + AT_TAB);
    if (MODE == 1) { for (int i = tid; i < 768; i += 512) { const int idx = i - 64; float v = 0.f;
            if (idx >= 0 && idx < 480) { const int dr = idx >> 5, dc = idx & 31; if (dc < 31) v = p.na_rpb[((size_t)(l * 8 + h) * 15 + dr) * 31 + dc] * 1.4426950408889634f; }
            tab[i] = v; } }
    const int NT = n0 + n1;
    auto issueK = [&](int t, int s) {
      for (int rr_ = 0; rr_ < REP_DMA; ++rr_) {
        const int tb = t < n0 ? kb0 + 64 * t : kb1 + 64 * (t - n0); LAS unsigned char* slot = lds + s * KB;
        if (MODE == 0) {
#pragma unroll
            for (int i = 0; i < 2; ++i) { const int id = wid * 2 + i;
                __builtin_amdgcn_global_load_lds((const unsigned*)(p.QKV() + (size_t)(tb + 8 * (id & 7) + (lane & 7)) * 3072 + kcol + (id >> 3) * 64 + ((lane >> 3) ^ (id & 1)) * 8), (LAS unsigned*)(slot + (id >> 3) * 8192 + (id & 7) * 1024), 16, 0, 0); }
        } else __builtin_amdgcn_global_load_lds((const unsigned*)(p.QKV() + (size_t)(tb + 8 * wid + (lane & 7)) * 3072 + kcol + ((lane >> 3) ^ (wid & 1)) * 8), (LAS unsigned*)(slot + wid * 1024), 16, 0, 0);
      }
    };
    auto issueV = [&](int t, int s) {
      for (int rr_ = 0; rr_ < REP_DMA; ++rr_) {
        const int tb = t < n0 ? kb0 + 64 * t : kb1 + 64 * (t - n0); LAS unsigned char* slot = lds + 3 * KB + s * VB;
        if (MODE == 0) {
#pragma unroll
            for (int i = 0; i < 2; ++i) { const int id = wid * 2 + i;
                __builtin_amdgcn_global_load_lds((const unsigned*)(p.QKV() + (size_t)(tb + 16 * (id & 3) + (lane >> 2)) * 3072 + vcol + 32 * (id >> 2) + (lane & 3) * 8), (LAS unsigned*)(slot + (id >> 2) * 4096 + (id & 3) * 1024), 16, 0, 0); }
        } else __builtin_amdgcn_global_load_lds((const unsigned*)(p.QKV() + (size_t)(tb + 16 * (wid & 3) + (lane >> 2)) * 3072 + vcol + 32 * (wid >> 2) + (lane & 3) * 8), (LAS unsigned*)(slot + (wid >> 2) * 4096 + (wid & 3) * 1024), 16, 0, 0);
      }
    };
    auto tile_act = [&](int t) -> bool { if (MODE != 1 || t >= n0) return true; const int j = j0 + t; return (j >= rsA) && (j < rsB + 8); };
    auto qk_load = [&](int t, int sl, bf16x8 (&kf)[8]) {
        const bool nbt = (MODE == 1) && (t < n0);
        const int kb_ = ((nbt ? ks0 : 0) + r32) >> 3; const LAS unsigned char* kp = lds + sl * KB + (nbt ? 0 : msub * 8192) + kb_ * 1024 + (r32 & 7) * 16 + ((hi ^ (kb_ & 1)) * 128);
#pragma unroll
        for (int d0 = 0; d0 < 4; ++d0) kf[2 * d0] = *(const LAS bf16x8*)(kp + d0 * 256);
        if (!nbt) {
#pragma unroll
            for (int d0 = 0; d0 < 4; ++d0) kf[2 * d0 + 1] = *(const LAS bf16x8*)(kp + d0 * 256 + 4096); }
    };
    auto qk_mma = [&](int t, const bf16x8 (&kf)[8], f32x16& a0, f32x16& a1, float init) {
        if (MODE == 1 && t < n0) {
#pragma unroll
            for (int r = 0; r < 16; ++r) a0[r] = init;
#pragma unroll
            for (int d0 = 0; d0 < 4; ++d0) a0 = __builtin_amdgcn_mfma_f32_32x32x16_bf16(kf[2 * d0], qr[d0], a0, 0, 0, 0);
        } else {
#pragma unroll
            for (int r = 0; r < 16; ++r) { a0[r] = init; a1[r] = init; }
#pragma unroll
            for (int d0 = 0; d0 < 4; ++d0) { a0 = __builtin_amdgcn_mfma_f32_32x32x16_bf16(kf[2 * d0], qr[d0], a0, 0, 0, 0); a1 = __builtin_amdgcn_mfma_f32_32x32x16_bf16(kf[2 * d0 + 1], qr[d0], a1, 0, 0, 0); }
        }
    };
    f32x16 o[ND];
#pragma unroll
    for (int d0 = 0; d0 < ND; ++d0)
#pragma unroll
        for (int r = 0; r < 16; ++r) o[d0][r] = 0.f;
    float mref = 0.f;
    f32x16 osum;
#pragma unroll
    for (int r = 0; r < 16; ++r) osum[r] = 0.f;
    const bf16x8 ones = (bf16x8){16256, 16256, 16256, 16256, 16256, 16256, 16256, 16256};
    f32x16 c0, c1;
    u32x4 pw[4];
#pragma unroll
    for (int r = 0; r < 16; ++r) c1[r] = 0.f;
#define AT_BAR do { asm volatile("s_waitcnt lgkmcnt(0)" ::: "memory"); __builtin_amdgcn_s_barrier(); __builtin_amdgcn_sched_barrier(0); } while (0)
#define AT_WV0 asm volatile("s_waitcnt vmcnt(0)" ::: "memory")
    issueK(0, 0); issueV(0, 0); if (NT > 1) { issueK(1, 1); issueV(1, 1); } if (NT > 2) issueK(2, 2);
    AT_WV0;
    AT_BAR;
    const int grp = wid >> 2;
    int s0 = 0, s1 = 1, s2 = 2;
    auto issueKV = [&](int t) { if (t + 3 < NT) issueK(t + 3, s0); if (t + 2 < NT) issueV(t + 2, s2); };
    auto waitKV = [&](int t) { if (t + 3 < NT) { if (MODE == 0) asm volatile("s_waitcnt vmcnt(4)" ::: "memory"); else asm volatile("s_waitcnt vmcnt(2)" ::: "memory"); } else AT_WV0; };
    auto Vph = [&](int t) {
        if (!tile_act(t)) return;
        const bool nb = (MODE == 1) && (t < n0);
        float rm;
        if (nb) { const int j = j0 + t, dr = j - rq + 7; const bool rowact = (j >= rs_q) && (j < rs_q + 8);
            const LAS float* tb_ = tab + 64 + dr * 32 + (ks0 + 4 * hi - qc + 15); const int kbase = rowact ? (ks0 + 4 * hi - cs) : 1000;
#pragma unroll
            for (int r = 0; r < 16; ++r) { const int ko = (r & 3) + 8 * (r >> 2); c0[r] = ((unsigned)(kbase + ko) < 16u) ? c0[r] + tb_[ko] : -1e30f; }
            float ra = __builtin_fmaxf(__builtin_fmaxf(c0[0], c0[1]), c0[2]), rb = __builtin_fmaxf(__builtin_fmaxf(c0[3], c0[4]), c0[5]);
            ra = __builtin_fmaxf(__builtin_fmaxf(ra, c0[6]), c0[7]); rb = __builtin_fmaxf(__builtin_fmaxf(rb, c0[8]), c0[9]);
            ra = __builtin_fmaxf(__builtin_fmaxf(ra, c0[10]), c0[11]); rb = __builtin_fmaxf(__builtin_fmaxf(rb, c0[12]), c0[13]);
            rm = __builtin_fmaxf(__builtin_fmaxf(ra, rb), __builtin_fmaxf(c0[14], c0[15]));
        } else {
            float ra = __builtin_fmaxf(__builtin_fmaxf(c0[0], c0[1]), c1[0]), rb = __builtin_fmaxf(__builtin_fmaxf(c0[2], c0[3]), c1[1]);
            ra = __builtin_fmaxf(__builtin_fmaxf(ra, c1[2]), c1[3]);
#pragma unroll
            for (int r = 4; r < 16; r += 4) { ra = __builtin_fmaxf(__builtin_fmaxf(ra, c0[r]), c0[r + 1]); rb = __builtin_fmaxf(__builtin_fmaxf(rb, c0[r + 2]), c0[r + 3]);
                ra = __builtin_fmaxf(__builtin_fmaxf(ra, c1[r]), c1[r + 1]); rb = __builtin_fmaxf(__builtin_fmaxf(rb, c1[r + 2]), c1[r + 3]); }
            rm = __builtin_fmaxf(ra, rb);
        }
        rm = __builtin_fmaxf(rm, __shfl_xor(rm, 32));
        const bool mv = (rm > 8.f) || (rm < -40.f && rm > -1e29f);
        if (__any(mv)) {
            const float dl = mv ? rm : 0.f; mref += dl; const float f = __builtin_amdgcn_exp2f(-dl);
#pragma unroll
            for (int r = 0; r < 16; ++r) { c0[r] -= dl; c1[r] -= dl; }
            if (hi == 0) wsf[r32] = f;
            __builtin_amdgcn_s_waitcnt(0xc07f);
#pragma unroll
            for (int r = 0; r < 16; ++r) { const float fr_ = wsf[crow(r, hi)]; osum[r] *= fr_;
#pragma unroll
                for (int d0 = 0; d0 < ND; ++d0) o[d0][r] *= fr_; }
        }
        if (nb) {
#pragma unroll
            for (int r = 0; r < 16; ++r) c0[r] = __builtin_amdgcn_exp2f(c0[r]);
#pragma unroll
            for (int k = 0; k < 2; ++k) pw[k] = (u32x4){cvt_pk_bf16(c0[8 * k], c0[8 * k + 1]), cvt_pk_bf16(c0[8 * k + 2], c0[8 * k + 3]), cvt_pk_bf16(c0[8 * k + 4], c0[8 * k + 5]), cvt_pk_bf16(c0[8 * k + 6], c0[8 * k + 7])};
            asm volatile("" : "+v"(pw[0]), "+v"(pw[1]));
        } else {
#pragma unroll
            for (int r = 0; r < 16; ++r) {
#if REP_XP > 1
                { float d0_ = __builtin_amdgcn_exp2f(c0[r] - 1.f), d1_ = __builtin_amdgcn_exp2f(c1[r] - 1.f); asm volatile("" :: "v"(d0_), "v"(d1_)); }
#endif
                c0[r] = __builtin_amdgcn_exp2f(c0[r]); c1[r] = __builtin_amdgcn_exp2f(c1[r]); }
#pragma unroll
            for (int k = 0; k < 2; ++k) {
                pw[k] = (u32x4){cvt_pk_bf16(c0[8 * k], c0[8 * k + 1]), cvt_pk_bf16(c0[8 * k + 2], c0[8 * k + 3]), cvt_pk_bf16(c0[8 * k + 4], c0[8 * k + 5]), cvt_pk_bf16(c0[8 * k + 6], c0[8 * k + 7])};
                pw[2 + k] = (u32x4){cvt_pk_bf16(c1[8 * k], c1[8 * k + 1]), cvt_pk_bf16(c1[8 * k + 2], c1[8 * k + 3]), cvt_pk_bf16(c1[8 * k + 4], c1[8 * k + 5]), cvt_pk_bf16(c1[8 * k + 6], c1[8 * k + 7])}; }
            asm volatile("" : "+v"(pw[0]), "+v"(pw[1]), "+v"(pw[2]), "+v"(pw[3]));
        }
    };
#define AT_SB __builtin_amdgcn_sched_barrier(0)
#define AT_VTR(dst, addr, off) asm volatile("ds_read_b64_tr_b16 %0, %1 offset:%2" : "=v"(dst) : "v"(addr), "n"(off) : "memory")
#define AT_VW(n, f0, f1, f2, f3) asm volatile("s_waitcnt lgkmcnt(" #n ")" : "+v"(f0), "+v"(f1), "+v"(f2), "+v"(f3) :: "memory")
    auto Mph = [&](int t) {
        const bool act = tile_act(t), actn = (t + 1 < NT) && tile_act(t + 1);
        bf16x8 kf[8];
        if (actn) qk_load(t + 1, s1, kf);
        if (act) {
            const bool nb = (MODE == 1) && (t < n0);
            const unsigned va = (unsigned)(size_t)(lds + 3 * KB + s0 * VB + ((lane >> 4) & 1) * 32 + (lane & 3) * 8 + (4 * hi + ((lane & 15) >> 2)) * 64);
            if (nb) {
                const unsigned vb = va + (unsigned)(ks0 >> 3) * 512u;
                s16x4 l00, h00, l01, h01, l10, h10, l11, h11;
                AT_VTR(l00, vb, 0); AT_VTR(h00, vb, 512); AT_VTR(l01, vb, 1024); AT_VTR(h01, vb, 1536);
                AT_VTR(l10, vb, 4096); AT_VTR(h10, vb, 4608); AT_VTR(l11, vb, 5120); AT_VTR(h11, vb, 5632);
                bf16x8 f00 = (bf16x8){l00[0], l00[1], l00[2], l00[3], h00[0], h00[1], h00[2], h00[3]}, f01 = (bf16x8){l01[0], l01[1], l01[2], l01[3], h01[0], h01[1], h01[2], h01[3]};
                bf16x8 f10 = (bf16x8){l10[0], l10[1], l10[2], l10[3], h10[0], h10[1], h10[2], h10[3]}, f11 = (bf16x8){l11[0], l11[1], l11[2], l11[3], h11[0], h11[1], h11[2], h11[3]};
                AT_SB;
#pragma unroll
                for (int ks = 0; ks < 2; ++ks) osum = __builtin_amdgcn_mfma_f32_32x32x16_bf16(__builtin_bit_cast(bf16x8, pw[ks]), ones, osum, 0, 0, 0);
                AT_VW(0, f00, f01, f10, f11);
                AT_SB;
                o[0] = __builtin_amdgcn_mfma_f32_32x32x16_bf16(__builtin_bit_cast(bf16x8, pw[0]), f00, o[0], 0, 0, 0);
                o[1] = __builtin_amdgcn_mfma_f32_32x32x16_bf16(__builtin_bit_cast(bf16x8, pw[0]), f10, o[1], 0, 0, 0);
                o[0] = __builtin_amdgcn_mfma_f32_32x32x16_bf16(__builtin_bit_cast(bf16x8, pw[1]), f01, o[0], 0, 0, 0);
                o[1] = __builtin_amdgcn_mfma_f32_32x32x16_bf16(__builtin_bit_cast(bf16x8, pw[1]), f11, o[1], 0, 0, 0);
                AT_SB;
            } else {
                bf16x8 vf[2][4];
#define AT_LDV(set, d0) do { s16x4 l0_, h0_, l1_, h1_, l2_, h2_, l3_, h3_; \
    AT_VTR(l0_, va, (d0) * 4096); AT_VTR(h0_, va, (d0) * 4096 + 512); AT_VTR(l1_, va, (d0) * 4096 + 1024); AT_VTR(h1_, va, (d0) * 4096 + 1536); \
    AT_VTR(l2_, va, (d0) * 4096 + 2048); AT_VTR(h2_, va, (d0) * 4096 + 2560); AT_VTR(l3_, va, (d0) * 4096 + 3072); AT_VTR(h3_, va, (d0) * 4096 + 3584); \
    vf[set][0] = (bf16x8){l0_[0], l0_[1], l0_[2], l0_[3], h0_[0], h0_[1], h0_[2], h0_[3]}; vf[set][1] = (bf16x8){l1_[0], l1_[1], l1_[2], l1_[3], h1_[0], h1_[1], h1_[2], h1_[3]}; \
    vf[set][2] = (bf16x8){l2_[0], l2_[1], l2_[2], l2_[3], h2_[0], h2_[1], h2_[2], h2_[3]}; vf[set][3] = (bf16x8){l3_[0], l3_[1], l3_[2], l3_[3], h3_[0], h3_[1], h3_[2], h3_[3]}; } while (0)
                AT_LDV(0, 0);
                AT_SB;
#pragma unroll
                for (int ks = 0; ks < 4; ++ks) osum = __builtin_amdgcn_mfma_f32_32x32x16_bf16(__builtin_bit_cast(bf16x8, pw[ks]), ones, osum, 0, 0, 0);
                AT_LDV(1, 1);
                AT_VW(8, vf[0][0], vf[0][1], vf[0][2], vf[0][3]);
                AT_SB;
#pragma unroll
                for (int ks = 0; ks < 4; ++ks) o[0] = __builtin_amdgcn_mfma_f32_32x32x16_bf16(__builtin_bit_cast(bf16x8, pw[ks]), vf[0][ks], o[0], 0, 0, 0);
#if REP_PV > 1
                { const bf16x8 zz = (bf16x8){0,0,0,0,0,0,0,0};
#pragma unroll
                  for (int d0 = 0; d0 < ND; ++d0)
#pragma unroll
                    for (int ks = 0; ks < 4; ++ks) o[d0] = __builtin_amdgcn_mfma_f32_32x32x16_bf16(zz, vf[0][ks], o[d0], 0, 0, 0); }
#endif
                AT_SB;
                if (ND == 4) {
                    AT_LDV(0, 2);
                    AT_VW(8, vf[1][0], vf[1][1], vf[1][2], vf[1][3]);
                    AT_SB;
#pragma unroll
                    for (int ks = 0; ks < 4; ++ks) o[1] = __builtin_amdgcn_mfma_f32_32x32x16_bf16(__builtin_bit_cast(bf16x8, pw[ks]), vf[1][ks], o[1], 0, 0, 0);
                    AT_SB;
                    AT_LDV(1, 3);
                    AT_VW(8, vf[0][0], vf[0][1], vf[0][2], vf[0][3]);
                    AT_SB;
#pragma unroll
                    for (int ks = 0; ks < 4; ++ks) o[ND - 2] = __builtin_amdgcn_mfma_f32_32x32x16_bf16(__builtin_bit_cast(bf16x8, pw[ks]), vf[0][ks], o[ND - 2], 0, 0, 0);
                    AT_SB;
                }
                AT_VW(0, vf[1][0], vf[1][1], vf[1][2], vf[1][3]);
                AT_SB;
#pragma unroll
                for (int ks = 0; ks < 4; ++ks) o[ND - 1] = __builtin_amdgcn_mfma_f32_32x32x16_bf16(__builtin_bit_cast(bf16x8, pw[ks]), vf[1][ks], o[ND - 1], 0, 0, 0);
                AT_SB;
            }
        }
        if (actn) qk_mma(t + 1, kf, c0, c1, -mref);
    };
    if (grp) AT_BAR;
    if (tile_act(0)) { bf16x8 kf0[8]; qk_load(0, 0, kf0); qk_mma(0, kf0, c0, c1, 0.f); }
    AT_BAR;
    for (int t = 0; t < NT; ++t) {
        if (grp == 1) issueKV(t);
        Vph(t);
        if (grp == 0) waitKV(t - 1);
        AT_BAR;
        if (grp == 0) issueKV(t);
        Mph(t);
        if (grp == 1) waitKV(t);
        AT_BAR;
        { const int s_ = s0; s0 = s1; s1 = s2; s2 = s_; }
    }
    if (!grp) AT_BAR;
    float rl[16];
    { const float lamf = (MODE == 0 && msub == 1) ? p.LAM()[l] : 1.f;
#pragma unroll
      for (int r = 0; r < 16; ++r) rl[r] = lamf * __builtin_amdgcn_rcpf(osum[r]); }
    if (MODE == 0) {
        LAS float* x1 = (LAS float*)(lds + AT_X1) + (wid & 3) * 4096 + lane;
        if (msub == 1) {
#pragma unroll
            for (int d0 = 0; d0 < ND; ++d0)
#pragma unroll
                for (int r = 0; r < 16; ++r) x1[(d0 * 16 + r) * 64] = o[d0][r] * rl[r];
        }
        __syncthreads();
        if (msub == 0) {
            LAS float* st = (LAS float*)(lds + wid * 16896);
#pragma unroll
            for (int d0 = 0; d0 < ND; ++d0)
#pragma unroll
                for (int r = 0; r < 16; ++r) st[crow(r, hi) * 132 + d0 * 32 + r32] = o[d0][r] * rl[r] - x1[(d0 * 16 + r) * 64];
            __builtin_amdgcn_s_waitcnt(0xc07f);
            const int q = lane >> 1, half = lane & 1;
            f32x4 v[16]; float ss = 0.f;
#pragma unroll
            for (int i = 0; i < 16; ++i) { v[i] = *(const LAS f32x4*)(st + q * 132 + half * 64 + i * 4); ss += v[i][0] * v[i][0] + v[i][1] * v[i][1] + v[i][2] * v[i][2] + v[i][3] * v[i][3]; }
            ss += __shfl_xor(ss, 1);
            const float rn = rsqrtf(ss * (1.f / 128.f) + EPS) * (1.f - (0.8f - 0.6f * __expf(-0.3f * (float)l)));
            const float* g = p.da_subln_g + l * 128 + half * 64;
            bf16_t* dst = p.O() + (size_t)(qbase + q) * 1536 + h * 128 + half * 64;
#pragma unroll
            for (int i = 0; i < 8; ++i) { const f32x4 ga = *(const f32x4*)(g + i * 8), gb = *(const f32x4*)(g + i * 8 + 4); const f32x4 a = v[2 * i] * ga * rn, b = v[2 * i + 1] * gb * rn;
                u32x4 w; w.x = cvt_pk_bf16(a[0], a[1]); w.y = cvt_pk_bf16(a[2], a[3]); w.z = cvt_pk_bf16(b[0], b[1]); w.w = cvt_pk_bf16(b[2], b[3]);
                *(u32x4*)(dst + i * 8) = w; }
        }
    } else {
        LAS bf16_t* stg = (LAS bf16_t*)(lds + AT_X1 + wid * 4096);
#pragma unroll
        for (int r = 0; r < 16; ++r)
#pragma unroll
            for (int d0 = 0; d0 < ND; ++d0) stg[crow(r, hi) * 64 + d0 * 32 + r32] = f2bf(o[d0][r] * rl[r]);
        __builtin_amdgcn_s_waitcnt(0xc07f);
#pragma unroll
        for (int i = 0; i < 4; ++i) { const int row = i * 8 + (lane >> 3), ch = lane & 7; const u32x4 v = *(const LAS u32x4*)(stg + row * 64 + ch * 8);
            const int tok = (MODE == 1) ? qrow0 + (2 * rp + (row >> 4)) * 64 + 16 * g + (row & 15) : qbase + row;
            *(u32x4*)(p.O() + (size_t)tok * 1536 + 512 + h * 64 + ch * 8) = v; }
    }
    __syncthreads();
}

constexpr int LDS_BARW = LDS_TOTAL - 64;

#define XB_TMO      128
#define XB_XCNT(j)  (256  + 64 * (j))
#define XB_XSUB(j)  (1280 + 64 * (j))
#define XB_XGEN(j)  (2304 + 64 * (j))
#define XB_TOP      3328
#define XB_TOPGEN   3392
#define XCD_BAR_WORDS 3456
#define XB_SPIN_CAP (1u << 18)

__device__ __forceinline__ unsigned xb_ld(unsigned* p)              { return __hip_atomic_load(p, __ATOMIC_RELAXED, __HIP_MEMORY_SCOPE_AGENT); }
__device__ __forceinline__ unsigned xb_add(unsigned* p, unsigned v) { return __hip_atomic_fetch_add(p, v, __ATOMIC_RELAXED, __HIP_MEMORY_SCOPE_AGENT); }
__device__ __forceinline__ unsigned xb_xcc_id() { return (unsigned)__builtin_amdgcn_s_getreg((3 << 11) | 20) & 0xFu; }
#define XB_SPIN(cond, bar) do { unsigned _sp = 0; while (cond) { __builtin_amdgcn_s_sleep(1); \
    if ((++_sp & 255u) == 0u) { if (xb_ld(&(bar)[XB_TMO])) break; if (_sp > XB_SPIN_CAP) { atomicAdd(&(bar)[XB_TMO], 1u); break; } } } } while (0)

struct XcdBarrier {
    unsigned* bar; unsigned x;
    volatile LAS unsigned* st;
};

__device__ __forceinline__ XcdBarrier xcd_barrier_post(unsigned* bar, volatile LAS unsigned* st) {
    XcdBarrier b; b.bar = bar; b.x = xb_xcc_id(); b.st = st;
    if (threadIdx.x == 0) (void)xb_add(&bar[XB_XCNT(b.x)], 1u);
    return b;
}
__device__ __forceinline__ void xcd_barrier_complete(unsigned* bar, unsigned x, unsigned& nloc, unsigned& nx) {
    const unsigned G = gridDim.x * gridDim.y * gridDim.z;
    unsigned sum, cnt, mine, sp = 0u;
    for (;;) {
        sum = 0u; cnt = 0u; mine = 0u;
#pragma unroll
        for (unsigned j = 0; j < 16; ++j) { const unsigned c = xb_ld(&bar[XB_XCNT(j)]); sum += c; cnt += (c > 0u) ? 1u : 0u; mine = (j == x) ? c : mine; }
        if (sum == G) break;
        __builtin_amdgcn_s_sleep(1);
        if ((++sp & 255u) == 0u) { if (xb_ld(&bar[XB_TMO])) break; if (sp > XB_SPIN_CAP) { atomicAdd(&bar[XB_TMO], 1u); break; } }
    }
    nloc = mine > 0u ? mine : 1u; nx = cnt > 0u ? cnt : 1u;
}

__device__ __forceinline__ void xcd_barrier(const XcdBarrier& b) {
    asm volatile("s_waitcnt vmcnt(0)" ::: "memory");
    __syncthreads();
    if (threadIdx.x == 0) {
        unsigned* bar = b.bar;
        __builtin_amdgcn_s_waitcnt(0);
        unsigned nloc = b.st[0], nx = b.st[1];
        unsigned bx = b.x; asm volatile("" : "+s"(bx));
        if (nloc == 0u) { xcd_barrier_complete(bar, bx, nloc, nx); b.st[0] = nloc; b.st[1] = nx; }
        const unsigned old = xb_add(&bar[XB_XSUB(bx)], 1u);
        const unsigned gen = old / nloc;
        if (old + 1u == (gen + 1u) * nloc) {
            __builtin_amdgcn_fence(__ATOMIC_RELEASE, "agent");
            asm volatile("s_waitcnt vmcnt(0)" ::: "memory");
            const unsigned og = xb_add(&bar[XB_TOP], 1u);
            const unsigned tg = og / nx;
            if (og + 1u == (tg + 1u) * nx) xb_add(&bar[XB_TOPGEN], 1u);
            else XB_SPIN(xb_ld(&bar[XB_TOPGEN]) == tg, bar);
            __builtin_amdgcn_fence(__ATOMIC_ACQUIRE, "agent");
            xb_add(&bar[XB_XGEN(bx)], 1u);
            asm volatile("s_waitcnt vmcnt(0)" ::: "memory");
        } else {
            XB_SPIN(xb_ld(&bar[XB_XGEN(bx)]) == gen, bar);
            __builtin_amdgcn_fence(__ATOMIC_ACQUIRE, "agent");
            asm volatile("s_waitcnt vmcnt(0)" ::: "memory");
        }
    }
    __syncthreads();
}

__device__ __forceinline__ void row_combine(const P& p, int lprev, int row, int lane, float4 (&v)[4], float scale = 1.f) {
    const float* md = p.MOD() + (size_t)(lprev * 9 + modidx(row)) * NMOD + 5 * D;
    int ri[4];
#pragma unroll
    for (int k = 0; k < 4; ++k) ri[k] = p.ROWIDX()[row * 4 + k];
#pragma unroll
    for (int i = 0; i < 4; ++i) { const int c = (lane + 64 * i) * 4; float4 s = {0.f, 0.f, 0.f, 0.f};
#pragma unroll
        for (int k = 0; k < 4; ++k) { const ushort4 y = *(const ushort4*)(p.YS() + (size_t)ri[k] * D + c); s.x += bf2f(y.x); s.y += bf2f(y.y); s.z += bf2f(y.z); s.w += bf2f(y.w); }
        float4 g2 = *(const float4*)(md + c); g2.x *= scale; g2.y *= scale; g2.z *= scale; g2.w *= scale;
        v[i].x += g2.x * s.x; v[i].y += g2.y * s.y; v[i].z += g2.z * s.z; v[i].w += g2.w * s.w; }
}
__device__ __forceinline__ void row_combine_c(const P& p, const int (&ri)[4], int lane, float4 (&v)[4], const float4 (&g2)[4]) {
#pragma unroll
    for (int i = 0; i < 4; ++i) { const int c = (lane + 64 * i) * 4; float4 s = {0.f, 0.f, 0.f, 0.f};
#pragma unroll
        for (int k = 0; k < 4; ++k) { const ushort4 y = *(const ushort4*)(p.YS() + (size_t)ri[k] * D + c); s.x += bf2f(y.x); s.y += bf2f(y.y); s.z += bf2f(y.z); s.w += bf2f(y.w); }
        v[i].x += g2[i].x * s.x; v[i].y += g2[i].y * s.y; v[i].z += g2[i].z * s.z; v[i].w += g2[i].w * s.w; }
}
__device__ __forceinline__ void ph_norm1(const P& p, int l, int G, int c, float scale = 1.f) {
    const int t_ = otid(), wid = t_ >> 6, lane = t_ & 63;
    const float* g = p.nmg + l * D;
    const int RPB = (T + G - 1) / G;
    int cm = -1; float4 cA[4], cB[4], cG2[4];
#pragma unroll
    for (int i = 0; i < 4; ++i) { cA[i] = make_float4(0.f, 0.f, 0.f, 0.f); cB[i] = cA[i]; cG2[i] = cA[i]; }
    int rin[4] = {0, 0, 0, 0};
    if (l > 0 && wid < RPB && c * RPB + wid < T) {
#pragma unroll
        for (int k = 0; k < 4; ++k) rin[k] = p.ROWIDX()[(c * RPB + wid) * 4 + k]; }
    for (int ri = wid; ri < RPB; ri += 8) {
        const int row = c * RPB + ri; if (row >= T) break;
        int rcur[4] = {rin[0], rin[1], rin[2], rin[3]};
        if (l > 0 && ri + 8 < RPB && row + 8 < T) {
#pragma unroll
            for (int k = 0; k < 4; ++k) rin[k] = p.ROWIDX()[(row + 8) * 4 + k]; }
        const int m = modidx(row);
        if (m != cm) { cm = m; const float* md = p.MOD() + (size_t)(l * 9 + m) * NMOD;
#pragma unroll
            for (int i = 0; i < 4; ++i) { const int cc = (lane + 64 * i) * 4; const float4 gg = *(const float4*)(g + cc), sh = *(const float4*)(md + cc), sc = *(const float4*)(md + D + cc);
                cA[i] = make_float4(gg.x * (1.f + sc.x), gg.y * (1.f + sc.y), gg.z * (1.f + sc.z), gg.w * (1.f + sc.w)); cB[i] = sh;
                if (l > 0) { const float4 q = *(const float4*)(p.MOD() + (size_t)((l - 1) * 9 + m) * NMOD + 5 * D + cc); cG2[i] = make_float4(q.x * scale, q.y * scale, q.z * scale, q.w * scale); } } }
        float4 v[4];
        if (l == 0) { const float4* xr = (const float4*)(row < TX ? p.x + (size_t)row * D : p.ctx + (size_t)(row - TX) * D);
#pragma unroll
            for (int i = 0; i < 4; ++i) v[i] = xr[lane + 64 * i];
        } else {
#pragma unroll
            for (int i = 0; i < 4; ++i) v[i] = ldx4(p.X() + (size_t)row * D + (lane + 64 * i) * 4); }
        if (l > 0) row_combine_c(p, rcur, lane, v, cG2);
        float ss = 0.f;
#pragma unroll
        for (int i = 0; i < 4; ++i) { uint2 w; w.x = cvt_pk_bf16(v[i].x, v[i].y); w.y = cvt_pk_bf16(v[i].z, v[i].w); *(uint2*)(p.X() + (size_t)row * D + (lane + 64 * i) * 4) = w; ss += v[i].x * v[i].x + v[i].y * v[i].y + v[i].z * v[i].z + v[i].w * v[i].w; }
        ss = wave_sum(ss); const float rs = rsqrtf(ss * (1.f / D) + EPS);
#pragma unroll
        for (int i = 0; i < 4; ++i) { const int cc = (lane + 64 * i) * 4;
            ushort4 o; o.x = f2bf(v[i].x * rs * cA[i].x + cB[i].x); o.y = f2bf(v[i].y * rs * cA[i].y + cB[i].y); o.z = f2bf(v[i].z * rs * cA[i].z + cB[i].z); o.w = f2bf(v[i].w * rs * cA[i].w + cB[i].w);
            *(ushort4*)(p.H1() + (size_t)row * D + cc) = o; }
    }
}
__device__ __forceinline__ void ph_final(const P& p, int G, int c) {
    const int t_ = otid(), wid = t_ >> 6, lane = t_ & 63;
    const int RPB = (TX + G - 1) / G;
    int cm = -1; float4 cG2[4], cF[4];
#pragma unroll
    for (int i = 0; i < 4; ++i) { cF[i] = *(const float4*)(p.final_g + (lane + 64 * i) * 4); cG2[i] = make_float4(0.f, 0.f, 0.f, 0.f); }
    int rin[4] = {0, 0, 0, 0};
    if (wid < RPB && c * RPB + wid < TX) {
#pragma unroll
        for (int k = 0; k < 4; ++k) rin[k] = p.ROWIDX()[(c * RPB + wid) * 4 + k]; }
    for (int ri = wid; ri < RPB; ri += 8) {
        const int row = c * RPB + ri; if (row >= TX) break;
        int rcur[4] = {rin[0], rin[1], rin[2], rin[3]};
        if (ri + 8 < RPB && row + 8 < TX) {
#pragma unroll
            for (int k = 0; k < 4; ++k) rin[k] = p.ROWIDX()[(row + 8) * 4 + k]; }
        const int m = modidx(row);
        if (m != cm) { cm = m;
#pragma unroll
            for (int i = 0; i < 4; ++i) cG2[i] = *(const float4*)(p.MOD() + (size_t)((DEPTH - 1) * 9 + m) * NMOD + 5 * D + (lane + 64 * i) * 4); }
        float4 v[4];
#pragma unroll
        for (int i = 0; i < 4; ++i) v[i] = ldx4(p.X() + (size_t)row * D + (lane + 64 * i) * 4);
        row_combine_c(p, rcur, lane, v, cG2);
        float ss = 0.f;
#pragma unroll
        for (int i = 0; i < 4; ++i) ss += v[i].x * v[i].x + v[i].y * v[i].y + v[i].z * v[i].z + v[i].w * v[i].w;
        ss = wave_sum(ss); const float rs = rsqrtf(ss * (1.f / D) + EPS);
#pragma unroll
        for (int i = 0; i < 4; ++i) { const int cc = (lane + 64 * i) * 4;
            float4 o; o.x = v[i].x * rs * cF[i].x; o.y = v[i].y * rs * cF[i].y; o.z = v[i].z * rs * cF[i].z; o.w = v[i].w * rs * cF[i].w;
            *(float4*)(p.out + (size_t)row * D + cc) = o; }
    }
}
__device__ __forceinline__ void ph_norm2_route(const P& p, int l, int Tm, LAS unsigned char* lds, int G, int c, int* cntp, bf16_t* h2c, int* list, int* rowidx, float* sroww) {
    constexpr int HST = 1028;
    const int t_ = otid(), w = t_ >> 6, lane = t_ & 63, r32 = lane & 31, hi = lane >> 5;
    LAS float* hs = (LAS float*)lds;
    LAS float* part = (LAS float*)(lds + 24 * HST * 4);
    LAS int* cnt_l = (LAS int*)(lds + 24 * HST * 4 + 32768);
    LAS int* base_l = cnt_l + 32;
    LAS int* sv_e = base_l + 32;
    LAS int* sv_r = sv_e + 512; LAS float* sv_w = (LAS float*)(sv_r + 512);
    const float* g = p.nfg + l * D;
    const int RPB = (Tm + G - 1) / G, nchunk = (RPB + 23) / 24;
    const int e = lane & 31;
    const float brt = p.b_router[l * NEXP + e];
    bf16x8 bh[8], bl[8];
    { const bf16_t* wh = p.WrH() + ((size_t)l * NEXP + r32) * D + w * 128 + hi * 8; const bf16_t* wl = p.WrL() + ((size_t)l * NEXP + r32) * D + w * 128 + hi * 8;
#pragma unroll
      for (int ks = 0; ks < 8; ++ks) { bh[ks] = *(const bf16x8*)(wh + ks * 16); bl[ks] = *(const bf16x8*)(wl + ks * 16); } }
    int cm = -1; float4 cA[4], cB[4];
#pragma unroll
    for (int i = 0; i < 4; ++i) { cA[i] = make_float4(0.f, 0.f, 0.f, 0.f); cB[i] = cA[i]; }
    if (t_ < 32) cnt_l[t_] = 0;
    for (int ch = 0; ch < nchunk; ++ch) {
        int rowj[3]; bool okj[3];
#pragma unroll
        for (int j = 0; j < 3; ++j) { const int ri = ch * 24 + w * 3 + j; rowj[j] = c * RPB + ri; okj[j] = (ri < RPB) && (rowj[j] < Tm);
            LAS float* hrow = hs + (w * 3 + j) * HST;
            if (okj[j]) { const int row = rowj[j];
                float4 v[4]; float ss = 0.f;
#pragma unroll
                for (int i = 0; i < 4; ++i) { v[i] = ldx4(p.X() + (size_t)row * D + (lane + 64 * i) * 4); ss += v[i].x * v[i].x + v[i].y * v[i].y + v[i].z * v[i].z + v[i].w * v[i].w; }
                ss = wave_sum(ss); const float rs = rsqrtf(ss * (1.f / D) + EPS);
                const int m = modidx(row);
                if (m != cm) { cm = m; const float* md = p.MOD() + (size_t)(l * 9 + m) * NMOD;
#pragma unroll
                    for (int i = 0; i < 4; ++i) { const int cc = (lane + 64 * i) * 4; const float4 gg = *(const float4*)(g + cc), sh = *(const float4*)(md + 3 * D + cc), sc = *(const float4*)(md + 4 * D + cc);
                        cA[i] = make_float4(gg.x * (1.f + sc.x), gg.y * (1.f + sc.y), gg.z * (1.f + sc.z), gg.w * (1.f + sc.w)); cB[i] = sh; } }
#pragma unroll
                for (int i = 0; i < 4; ++i) { const int cc = (lane + 64 * i) * 4;
                    f32x4 h; h[0] = v[i].x * rs * cA[i].x + cB[i].x; h[1] = v[i].y * rs * cA[i].y + cB[i].y; h[2] = v[i].z * rs * cA[i].z + cB[i].z; h[3] = v[i].w * rs * cA[i].w + cB[i].w;
                    *(LAS f32x4*)(hrow + cc) = h; uint2 hw; hw.x = cvt_pk_bf16(h[0], h[1]); hw.y = cvt_pk_bf16(h[2], h[3]); *(uint2*)(h2c + (size_t)row * D + cc) = hw; } }
            else {
#pragma unroll
                for (int i = 0; i < 4; ++i) *(LAS f32x4*)(hrow + (lane + 64 * i) * 4) = (f32x4){0.f, 0.f, 0.f, 0.f}; } }
        __syncthreads();
        { f32x16 acc;
#pragma unroll
          for (int r = 0; r < 16; ++r) acc[r] = 0.f;
          const LAS float* hp = hs + (r32 < 24 ? r32 : 23) * HST + w * 128 + hi * 8;
#pragma unroll
          for (int ks = 0; ks < 8; ++ks) { const f32x4 x0 = *(const LAS f32x4*)(hp + ks * 16), x1 = *(const LAS f32x4*)(hp + ks * 16 + 4);
              const unsigned h01 = cvt_pk_bf16(x0[0], x0[1]), h23 = cvt_pk_bf16(x0[2], x0[3]), h45 = cvt_pk_bf16(x1[0], x1[1]), h67 = cvt_pk_bf16(x1[2], x1[3]);
              const unsigned l01 = cvt_pk_bf16(x0[0] - __uint_as_float(h01 << 16), x0[1] - __uint_as_float(h01 & 0xffff0000u)), l23 = cvt_pk_bf16(x0[2] - __uint_as_float(h23 << 16), x0[3] - __uint_as_float(h23 & 0xffff0000u));
              const unsigned l45 = cvt_pk_bf16(x1[0] - __uint_as_float(h45 << 16), x1[1] - __uint_as_float(h45 & 0xffff0000u)), l67 = cvt_pk_bf16(x1[2] - __uint_as_float(h67 << 16), x1[3] - __uint_as_float(h67 & 0xffff0000u));
              const bf16x8 ah = __builtin_bit_cast(bf16x8, (u32x4){h01, h23, h45, h67}), al = __builtin_bit_cast(bf16x8, (u32x4){l01, l23, l45, l67});
              acc = __builtin_amdgcn_mfma_f32_32x32x16_bf16(ah, bh[ks], acc, 0, 0, 0);
              acc = __builtin_amdgcn_mfma_f32_32x32x16_bf16(al, bh[ks], acc, 0, 0, 0);
              acc = __builtin_amdgcn_mfma_f32_32x32x16_bf16(ah, bl[ks], acc, 0, 0, 0); }
          LAS float* pw_ = part + w * 1024 + r32;
#pragma unroll
          for (int r = 0; r < 16; ++r) pw_[crow(r, hi) * 32] = acc[r]; }
        __syncthreads();
#pragma unroll
        for (int j = 0; j < 3; ++j) {
            float logit = brt;
#pragma unroll
            for (int q = 0; q < 8; ++q) logit += part[q * 1024 + (w * 3 + j) * 32 + e];
            float tv0, tv1, tv2, tv3; int ti0, ti1, ti2, ti3;
#define TOP1(TV, TI) { float bv = logit; int bi = e; \
            for (int o = 16; o; o >>= 1) { const float ov = __shfl_xor(bv, o); const int oi = __shfl_xor(bi, o); if (ov > bv || (ov == bv && oi < bi)) { bv = ov; bi = oi; } } \
            TV = bv; TI = bi; if (e == bi) logit = -INFINITY; }
            TOP1(tv0, ti0) TOP1(tv1, ti1) TOP1(tv2, ti2) TOP1(tv3, ti3)
#undef TOP1
            const float e1 = expf(tv1 - tv0), e2 = expf(tv2 - tv0), e3 = expf(tv3 - tv0); const float inv = 1.f / (1.f + e1 + e2 + e3);
            int ee = ti0; float ww = inv;
            if (lane == 1) { ee = ti1; ww = e1 * inv; } if (lane == 2) { ee = ti2; ww = e2 * inv; } if (lane == 3) { ee = ti3; ww = e3 * inv; }
            if (lane < 4 && okj[j]) { const int rk = __hip_atomic_fetch_add(cnt_l + ee, 1, __ATOMIC_RELAXED, __HIP_MEMORY_SCOPE_WORKGROUP); const int si = (ch * 24 + w * 3 + j) * 4 + lane; sv_e[si] = ee; sv_r[si] = rk; sv_w[si] = ww; }
        }
    }
    __syncthreads();
    if (t_ < 32) { const int n = cnt_l[t_]; base_l[t_] = n ? atomicAdd(&cntp[t_], n) : 0; }
    __syncthreads();
    for (int i = t_; i < RPB * 4; i += 512) { const int row = c * RPB + (i >> 2);
        if (row < Tm) { const int ee = sv_e[i], myrow = ee * CAP + base_l[ee] + sv_r[i]; rowidx[row * 4 + (i & 3)] = myrow; sroww[myrow] = sv_w[i]; list[myrow] = row; } }
}

struct CvtTile { const float* s; bf16_t* d; int ldsrc, Kdim; };
template <class F>
__device__ __forceinline__ void cvt_run(const F& tile_of, int first, int stride, int n, LAS unsigned char* lds) {
    const int tid = otid(), lane = tid & 63, w = tid >> 6;
    LAS float* tl = (LAS float*)lds + w * (64 * 33);
    if (n <= 0) return;
    const int lr = lane >> 3, lc = lane & 7;
    float4 va[8], vb[8];
    CvtTile ta = tile_of(first), tb = ta;
#define CVT_LD(V, T_) do { _Pragma("unroll") for (int i = 0; i < 8; ++i) { const f32x4 q_ = __builtin_nontemporal_load((const f32x4*)((T_).s + (size_t)(i * 8 + lr) * (T_).ldsrc + w * 32 + lc * 4)); V[i] = make_float4(q_[0], q_[1], q_[2], q_[3]); } } while (0)
#define CVT_W(V) do { _Pragma("unroll") for (int i = 0; i < 8; ++i) { LAS float* t = tl + (i * 8 + lr) * 33 + lc * 4; t[0] = V[i].x; t[1] = V[i].y; t[2] = V[i].z; t[3] = V[i].w; } } while (0)
#define CVT_R(T_) do { __builtin_amdgcn_s_waitcnt(0xc07f); \
        _Pragma("unroll") for (int i = 0; i < 4; ++i) { const int nn = i * 8 + lr; float a[8]; \
            _Pragma("unroll") for (int jj = 0; jj < 8; ++jj) a[jj] = tl[(lc * 8 + jj) * 33 + nn]; \
            u32x4 wv; wv.x = cvt_pk_bf16(a[0], a[1]); wv.y = cvt_pk_bf16(a[2], a[3]); wv.z = cvt_pk_bf16(a[4], a[5]); wv.w = cvt_pk_bf16(a[6], a[7]); \
            __builtin_nontemporal_store(wv, (u32x4*)((T_).d + (size_t)(w * 32 + nn) * (T_).Kdim + lc * 8)); } \
        __builtin_amdgcn_s_waitcnt(0xc07f); } while (0)
    CVT_LD(va, ta);
    if (n > 1) { tb = tile_of(first + stride); CVT_LD(vb, tb); }
    for (int it = 0; it < n; it += 2) {
        { const CvtTile done_ = ta; CVT_W(va);
          if (it + 2 < n) { ta = tile_of(first + (it + 2) * stride); CVT_LD(va, ta); }
          CVT_R(done_); }
        if (it + 1 < n) { const CvtTile done_ = tb; CVT_W(vb);
          if (it + 3 < n) { tb = tile_of(first + (it + 3) * stride); CVT_LD(vb, tb); }
          CVT_R(done_); }
    }
#undef CVT_LD
#undef CVT_W
#undef CVT_R
    __syncthreads();
}
struct SmallTiles { P p;
    __device__ __forceinline__ CvtTile operator()(int t) const { CvtTile r;
        if (t < 1536) { const int part = t / 768, u = t - part * 768, l = u / 192, rem = u - l * 192, ky = rem / 12, nx = rem - ky * 12;
            r.s = p.w_in + ((size_t)l * D + ky * 64) * INC + (part ? 3584 : 0) + nx * 256; r.d = p.WinT() + ((size_t)l * 7168 + (part ? 4096 : 0) + nx * 256) * D + ky * 64; r.ldsrc = INC; r.Kdim = D; }
        else if (t < 1920) { const int u = t - 1536, lb = u / 32, rem = u - lb * 32, ky = rem / 4, nx = rem - ky * 4;
            r.s = p.w_branch + ((size_t)lb * 512 + ky * 64) * D + nx * 256; r.d = p.WbT() + ((size_t)lb * D + nx * 256) * 512 + ky * 64; r.ldsrc = D; r.Kdim = 512; }
        else { const int u = t - 1920, l = u / 64, rem = u - l * 64, ky = rem / 4, nx = rem - ky * 4;
            r.s = p.w_out + ((size_t)l * D + ky * 64) * D + nx * 256; r.d = p.WoT() + ((size_t)l * D + nx * 256) * D + ky * 64; r.ldsrc = D; r.Kdim = D; }
        return r; } };
struct MoeTiles { P p; int l;
    __device__ __forceinline__ CvtTile operator()(int t) const { CvtTile r;
        if (t < 4096) { const int e = t >> 7, rem = t & 127, ky = rem >> 3, nx = rem & 7; const size_t le = (size_t)l * NEXP + e;
            r.s = p.w_gu + (le * D + ky * 64) * 2048 + nx * 256; r.d = p.WguT() + (le * 2048 + nx * 256) * D + ky * 64; r.ldsrc = 2048; r.Kdim = D; }
        else { const int u = t - 4096, e = u >> 6, rem = u & 63, ky = rem >> 2, nx = rem & 3; const size_t le = (size_t)l * NEXP + e;
            r.s = p.w_dn + (le * D + ky * 64) * D + nx * 256; r.d = p.WdT() + (le * D + nx * 256) * D + ky * 64; r.ldsrc = D; r.Kdim = D; }
        return r; } };
constexpr int MOE_CVT_BATCH = 8, MOE_CVT_NB = 6144 / MOE_CVT_BATCH;
__device__ __forceinline__ void ph_prologue(const P& p, LAS unsigned char* lds, int G, int c) {
    const int tid = otid(); const size_t gt = (size_t)c * 512 + tid, gs = (size_t)G * 512;
    if (c == 0 && tid < 256) { const int l = tid >> 6, lane = tid & 63; const float* d = p.da_lambda + l * 256;
        const float a = wave_sum(d[lane] * d[64 + lane]), b = wave_sum(d[128 + lane] * d[192 + lane]);
        if (lane == 0) p.LAM()[l] = expf(a) - expf(b) + (0.8f - 0.6f * expf(-0.3f * (float)l)); }
    for (size_t idx = gt; idx < (size_t)SEQ * 32; idx += gs) { const int s = (int)(idx >> 5), j = (int)(idx & 31), axis = j >> 4, i = j & 15;
        const float pos = axis == 0 ? (float)(s / 64) : (float)(s % 64); const float a = pos * powf(10000.f, -(float)i / 16.f);
        p.ROPE()[idx] = cosf(a); p.ROPE()[SEQ * 32 + idx] = sinf(a); }
    for (size_t idx = gt; idx < (size_t)512 * 512; idx += gs) { const int R = (int)(idx >> 9), k = (int)(idx & 511), t = R >> 8, r = R & 255, im = r >> 7, k2 = 128 * t + (r & 127), n2 = k & 255;
        const float a = (float)((k2 * n2) & 255) / 128.f; const float cv = cospif(a), sv = sinpif(a);
        p.CSX()[idx] = f2bf(im ? (k < 256 ? sv : cv) : (k < 256 ? cv : -sv)); }
    for (size_t idx = gt; idx < (size_t)256 * 512; idx += gs) { const int r = (int)(idx >> 9), k = (int)(idx & 511), kk = k & 255, n = (kk >> 5) + 8 * (kk & 31), m = (r * n) & 255; const float a = (float)m / 128.f;
        p.CSY()[idx] = f2bf(k < 256 ? cospif(a) : -sinpif(a)); }
    for (size_t idx = gt; idx < (size_t)1024 * 512; idx += gs) { const int r = (int)(idx >> 9), cc = (int)(idx & 511), part = r >> 9, g = (r >> 7) & 3, j = r & 127, gc = cc >> 7, ci = cc & 127;
        const float a = (float)((j * ci) & 127) / 64.f; p.DFTC()[idx] = (gc == g) ? f2bf(part ? sinpif(a) : cospif(a)) : (bf16_t)0; }
    for (size_t idx = gt; idx < (size_t)DEPTH * NEXP * D; idx += gs) { const int k = (int)(idx & (D - 1)), e = (int)((idx >> 10) & (NEXP - 1)), l = (int)(idx >> 15);
        const float wv = p.w_router[((size_t)l * D + k) * NEXP + e]; const bf16_t h = f2bf(wv); p.WrH()[idx] = h; p.WrL()[idx] = f2bf(wv - bf2f(h)); }
    for (size_t idx = gt; idx < (size_t)DEPTH * D * 128; idx += gs) { const size_t lk = idx >> 7; const int c4 = (int)(idx & 127) * 4; const float4 v = *(const float4*)(p.w_in + lk * INC + 3072 + c4);
        ushort4 o; o.x = f2bf(v.x); o.y = f2bf(v.y); o.z = f2bf(v.z); o.w = f2bf(v.w); *(ushort4*)(p.Wf() + lk * 512 + c4) = o; }
    { LAS float* sc = (LAS float*)lds; LAS float* red = sc + 9 * 1024;
      for (int i = tid; i < 9 * 1024; i += 512) { const int r = i >> 10, k = i & 1023; const float v = r < 8 ? p.c[r * 1024 + k] : p.c_ctx[k]; sc[i] = v / (1.f + expf(-v)); }
      __syncthreads();
      for (int it = c; it < DEPTH * 96; it += G) { const int l = it / 96, cg = it - l * 96, n = cg * 64 + (tid & 63), kg = tid >> 6;
          float acc[9];
#pragma unroll
          for (int r = 0; r < 9; ++r) acc[r] = 0.f;
          const float* w = p.w_mod + (size_t)l * 1024 * NMOD + n;
#pragma unroll 32
          for (int k = kg * 128; k < kg * 128 + 128; ++k) { const float wv = w[(size_t)k * NMOD];
#pragma unroll
              for (int r = 0; r < 9; ++r) acc[r] += sc[r * 1024 + k] * wv; }
#pragma unroll
          for (int r = 0; r < 9; ++r) red[(kg * 9 + r) * 64 + (tid & 63)] = acc[r];
          __syncthreads();
          for (int i = tid; i < 9 * 64; i += 512) { const int r = i >> 6, cc = i & 63, nn = cg * 64 + cc; float s = p.b_mod[l * NMOD + nn];
#pragma unroll
              for (int q = 0; q < 8; ++q) s += red[(q * 9 + r) * 64 + cc];
              p.MOD()[(size_t)(l * 9 + r) * NMOD + nn] = s; }
          __syncthreads(); } }
    { SmallTiles st{p}; const int n = (2176 - c + G - 1) / G; cvt_run(st, c, G, n, lds); }
}
struct GFuse {
    static constexpr bool PERM = true, GATHER = false, PRE = false;
    P p; int lda, ldb, K, G, c, pad;
    __device__ __forceinline__ bool next(int i, GUnit& u) const {
        const int L = i * G + c; if (L >= 64) return false;
        const int l = L >> 4, pm = (L >> 2) & 3, pn = L & 3; u.pm = pm; u.pn = pn; u.e = l; u.pad = 0;
        u.a0 = (const char*)(p.DFTC() + (size_t)pm * 256 * 512); u.a1 = u.a0 + (size_t)HALF * 512 * 2;
        u.b0 = (const char*)(p.Wf() + ((size_t)l * D + pn * 256) * 512); u.b1 = u.b0 + (size_t)HALF * 512 * 2; return true; }
    __device__ __forceinline__ bool epi(f32x4 (&acc)[2][2][4][2], const GUnit& u, int wr, int wc, int fr, int fq) const {
        const int row0 = u.pm * 256 + wr * 64 + fr;
#pragma unroll
        for (int ai = 0; ai < 2; ++ai)
#pragma unroll
            for (int m = 0; m < 4; ++m) { const int row = row0 + ai * HALF + m * 16;
#pragma unroll
                for (int bj = 0; bj < 2; ++bj) { const f32x4 v0 = acc[ai][bj][m][0], v1 = acc[ai][bj][m][1]; const int col0 = u.pn * 256 + bj * HALF + wc * 32 + 8 * fq;
                    u32x4 w; w.x = cvt_pk_bf16(v0[0], v0[1]); w.y = cvt_pk_bf16(v0[2], v0[3]); w.z = cvt_pk_bf16(v1[0], v1[1]); w.w = cvt_pk_bf16(v1[2], v1[3]);
                    *(u32x4*)(p.WinT() + ((size_t)u.e * 7168 + 3072 + row) * D + col0) = w; } }
        return false;
    }
};

__device__ __forceinline__ void unit_signal(int* ctr) {
    asm volatile("s_waitcnt vmcnt(0)" ::: "memory");
    __syncthreads();
    if (threadIdx.x == 0) { __builtin_amdgcn_fence(__ATOMIC_RELEASE, "agent"); asm volatile("s_waitcnt vmcnt(0)" ::: "memory");
        (void)__hip_atomic_fetch_add(ctr, 1, __ATOMIC_RELAXED, __HIP_MEMORY_SCOPE_AGENT); }
}
__device__ __forceinline__ void unit_wait(int* ctr, int need, unsigned* bar) {
    if (threadIdx.x == 0) { unsigned sp = 0;
        while (__hip_atomic_load(ctr, __ATOMIC_RELAXED, __HIP_MEMORY_SCOPE_AGENT) < need) { __builtin_amdgcn_s_sleep(2);
            if ((++sp & 255u) == 0u) { if (xb_ld(&bar[XB_TMO])) break; if (sp > (1u << 20)) { atomicAdd(&bar[XB_TMO], 1u); break; } } }
        __builtin_amdgcn_fence(__ATOMIC_ACQUIRE, "agent"); asm volatile("s_waitcnt vmcnt(0)" ::: "memory"); }
    __syncthreads();
}
__device__ __forceinline__ int grab(int* ctr, volatile LAS int* slot) {
    __syncthreads();
    if (threadIdx.x == 0) *slot = atomicAdd(ctr, 1);
    __syncthreads();
    return __builtin_amdgcn_readfirstlane(*slot);
}
__device__ __forceinline__ int grab_xcd(int* qx, int x, int nper, volatile LAS int* slot) {
    __syncthreads();
    if (threadIdx.x == 0) { int r = -1;
        for (int k = 0; k < 8; ++k) { const int xx = (x + k) & 7;
            if (__hip_atomic_load(qx + xx * 16, __ATOMIC_RELAXED, __HIP_MEMORY_SCOPE_AGENT) >= nper) continue;
            const int v = atomicAdd(qx + xx * 16, 1); if (v < nper) { r = xx * nper + v; break; } }
        *slot = r; }
    __syncthreads();
    return __builtin_amdgcn_readfirstlane(*slot);
}
typedef __attribute__((address_space(4))) const P* kparg_t;
__device__ __forceinline__ P load_p() {
#if defined(__HIP_DEVICE_COMPILE__)
    kparg_t kp = (kparg_t)__builtin_amdgcn_kernarg_segment_ptr(); asm volatile("" : "+s"(kp)); return *kp;
#else
    return P{};
#endif
}
#define XBAR(b) do { for (int rb_ = 0; rb_ < REP_BAR; ++rb_) xcd_barrier(b); } while (0)
__global__ __launch_bounds__(512, 2) __attribute__((amdgpu_waves_per_eu(2, 2))) void mega(P p_unused) {
    LAS unsigned char* lds = (LAS unsigned char*)dyn_smem;
    const int G = (int)gridDim.x, c = (int)blockIdx.x;
    volatile LAS unsigned* st = (volatile LAS unsigned*)(lds + LDS_BARW);
    volatile LAS int* slot = (volatile LAS int*)(lds + LDS_BARW + 8);
    if (threadIdx.x == 0) { st[0] = 0u; st[1] = 0u; st[2] = 0u; st[3] = 0u; }
    __syncthreads();
    const XcdBarrier bar = xcd_barrier_post(load_p().bar(), st);
    for (int rep = 0; rep < REP_PRO; ++rep) { const P p = load_p(); ph_prologue(p, lds, G, c);
    XBAR(bar); }
    { const P p = load_p(); GFuse g{p, 512, 512, 512, G, c, 0}; gemm_phase(lds, g); }
    XBAR(bar);
    for (int l = 0; l < DEPTH; ++l) {
        const bool last = (l == DEPTH - 1); const int Tm = last ? TX : T;
        for (int rep = 0; rep < REP_N1; ++rep) { const P p = load_p(); ph_norm1(p, l, G, c, rep == 0 ? 1.f : 0.f);
        XBAR(bar); }
        for (int rep = 0; rep < REP_INP; ++rep) { { const P p = load_p(); GInproj g{p, l, D, D, D, G, c}; gemm_phase(lds, g); }
        XBAR(bar); }
        { const P p = load_p(); int* q = p.QCTR() + l * 16; int* sig = p.SIG() + l * 9 * 32; unsigned* barw = p.bar(); int u; const int xq = (int)(bar.x & 7u);
          const MoeTiles mt_{p, l};
          if ((c & 3) == 0) { while ((u = grab(q + 5, slot)) < MOE_CVT_NB) cvt_run(mt_, u * MOE_CVT_BATCH, 1, MOE_CVT_BATCH, lds); }
          if (!last) {
              while ((u = grab(q + 3, slot)) < 16) { GFourY g{p, 512, 512, 512, u, 0, 0}; gemm_phase(lds, g); unit_signal(sig); }
              while ((u = grab(q + 4, slot)) < 64) { const int b = u >> 3, h = u & 7; attn_unit_seq<2>(p, l, lds, h, TX + b * CTX, TX + b * CTX, 4, 0, 0, 0, 0); unit_signal(sig); }
              while ((u = grab(q + 6, slot)) < 64) { const int b = u >> 3, h = (u >> 1) & 3, qb = u & 1; attn_unit<0>(p, l, lds, h, TX + b * CTX + qb * 128, TX + b * CTX, 4, 0, 0, 0, 0); unit_signal(sig); } }
          while ((u = grab(q + 0, slot)) < 256 * REP_FX) { GFourX g{p, 512, 512, 512, u & 255, 0, 0}; gemm_phase(lds, g); }
          if (!last) { while ((u = grab(q + 7, slot)) < 32) { unit_wait(sig, 144, barw); GMerge g{p, l, 64, 1536, 512, 512, G, c, u}; gemm_phase(lds, g); unit_signal(sig + 32 * (1 + (u >> 2))); } }
          while ((u = grab_xcd(p.XQ() + (l * 2 + 0) * 128, xq, 64 * REP_DA, slot)) >= 0) { const int pr = u / (64 * REP_DA) + 8 * ((u >> 4) & 3), b = pr >> 2, h = pr & 3, qb = u & 15;
              attn_unit<0>(p, l, lds, h, b * SEQ + qb * 128, b * SEQ, 32, TX + b * CTX, 4, 0, 0); }
          while ((u = grab_xcd(p.XQ() + (l * 2 + 1) * 128, xq, 64 * REP_NA, slot)) >= 0) { const int pr = u / (64 * REP_NA) + 8 * ((u >> 3) & 7), b = pr >> 3, h = pr & 7, R0 = (u & 7) * 4;
              const int j0 = min(max(R0 - 4, 0), 24), je = min(max(R0 - 1, 0), 24) + 8;
              attn_unit_seq<1>(p, l, lds, h, b * SEQ + R0 * 64, b * SEQ + j0 * 64, je - j0, TX + b * CTX, 4, R0, j0); }
          if (!last) { while ((u = grab(q + 8, slot)) < 32) { unit_wait(sig + 32 * (1 + (u >> 2)), 4, barw); GOut g{p, l, 64, D, D, D, G, c, u, 1.f, 0}; gemm_phase(lds, g); } }
          while ((u = grab(q + 5, slot)) < MOE_CVT_NB) cvt_run(mt_, u * MOE_CVT_BATCH, 1, MOE_CVT_BATCH, lds);
        XBAR(bar); }
        { { const P p = load_p(); GMerge g{p, l, 64, 1536, 512, 512, G, c, -1}; gemm_phase(lds, g); }
        XBAR(bar); }
        { { const P p = load_p(); GOut g{p, l, 64, D, D, D, G, c, -1, 1.f, 0}; gemm_phase(lds, g); }
        XBAR(bar); }
        for (int rep = 0; rep < REP_N2; ++rep) { const P p = load_p(); if (rep == 0) ph_norm2_route(p, l, Tm, lds, G, c, p.CNT() + l * NEXP, p.H1(), p.LIST(), p.ROWIDX(), p.SROWW()); else ph_norm2_route(p, l, Tm, lds, G, c, p.CNT() + 128 + l * NEXP, p.ACT(), (int*)p.Mf() + (size_t)T * 8, (int*)p.Mf(), p.Mf() + (size_t)T * 4);
        XBAR(bar); }
        for (int rep = 0; rep < REP_GU; ++rep) { const P p = load_p(); LAS int* mtb = (LAS int*)(lds + LDS_SCRATCH); moe_tiles(p, l, mtb); GGateUp g{p, mtb, l, D, D, D, G, c, (rep > 0 && REP_GU_CHEAP) ? 1 : 0, 0}; gemm_phase(lds, g);
          if (TAIL_CVT && l + 1 < DEPTH) { const int U = mtb[NEXP] * 8; if ((U - c + G - 1) / G < (U + G - 1) / G) { const MoeTiles mt2{p, l + 1}; const int u2 = grab(p.QCTR() + (l + 1) * 16 + 5, slot); if (u2 < MOE_CVT_NB) cvt_run(mt2, u2 * MOE_CVT_BATCH, 1, MOE_CVT_BATCH, lds); } }
        XBAR(bar); }
        for (int rep = 0; rep < REP_DN; ++rep) { const P p = load_p(); LAS int* mtb = (LAS int*)(lds + LDS_SCRATCH); moe_tiles(p, l, mtb); GDown g{p, mtb, l, D, D, D, G, c}; gemm_phase(lds, g);
          if (TAIL_CVT && l + 1 < DEPTH) { const int U = mtb[NEXP] * 4; if ((U - c + G - 1) / G < (U + G - 1) / G) { const MoeTiles mt2{p, l + 1}; const int u2 = grab(p.QCTR() + (l + 1) * 16 + 5, slot); if (u2 < MOE_CVT_NB) cvt_run(mt2, u2 * MOE_CVT_BATCH, 1, MOE_CVT_BATCH, lds); } }
        XBAR(bar); }
    }
    { const P p = load_p(); ph_final(p, G, c); }
}

extern "C" void kernel_launch(void* const* d_in, const int* in_sizes, int n_in, void* d_out, int out_size, void* d_ws, size_t ws_size, hipStream_t stream) {
    P p{};
    p.x = (const float*)d_in[0]; p.c = (const float*)d_in[1]; p.ctx = (const float*)d_in[2]; p.c_ctx = (const float*)d_in[3]; p.w_mod = (const float*)d_in[4]; p.b_mod = (const float*)d_in[5];
    p.nmg = (const float*)d_in[6]; p.nfg = (const float*)d_in[7]; p.w_in = (const float*)d_in[8]; p.da_lambda = (const float*)d_in[9]; p.da_subln_g = (const float*)d_in[10]; p.na_rpb = (const float*)d_in[11];
    p.w_branch = (const float*)d_in[12]; p.w_out = (const float*)d_in[13]; p.w_router = (const float*)d_in[14]; p.b_router = (const float*)d_in[15]; p.w_gu = (const float*)d_in[16]; p.b_gu = (const float*)d_in[17];
    p.w_dn = (const float*)d_in[18]; p.b_dn = (const float*)d_in[19]; p.final_g = (const float*)d_in[20]; p.out = (float*)d_out;
    p.ws = (char*)d_ws;
    if (WS_NEED > ws_size) { fprintf(stderr, "workspace too small: need %zu have %zu\n", (size_t)WS_NEED, ws_size); return; }
    static int grid = 0;
    if (!grid) {
        (void)hipFuncSetAttribute((const void*)mega, hipFuncAttributeMaxDynamicSharedMemorySize, LDS_TOTAL);
        int dev = 0, cus = 0, per_cu = 0; (void)hipGetDevice(&dev); (void)hipDeviceGetAttribute(&cus, hipDeviceAttributeMultiprocessorCount, dev);
        (void)hipOccupancyMaxActiveBlocksPerMultiprocessor(&per_cu, (const void*)mega, 512, LDS_TOTAL);
        grid = (per_cu >= 1) ? (cus / 8) * 8 : 0; if (grid > 256) grid = 256;
        if (grid <= 0) { fprintf(stderr, "mega: no resident grid (cus %d per_cu %d)\n", cus, per_cu); grid = 0; return; }
    }
    (void)hipMemsetAsync(p.ws + OFF_CTL, 0, SZ_CTL, stream);
    mega<<<grid, 512, LDS_TOTAL, stream>>>(p);
}
```

```cpp
#include <hip/hip_runtime.h>
#include <hip/hip_bf16.h>
#include <stdint.h>
#include <stdio.h>
#ifndef REP_PRO
#define REP_PRO 1
#endif
#ifndef REP_INP
#define REP_INP 1
#endif
#ifndef REP_MIX
#define REP_MIX 1
#endif
#ifndef REP_MG
#define REP_MG 1
#endif
#ifndef REP_GU
#define REP_GU 1
#endif
#ifndef REP_DN
#define REP_DN 1
#endif
#ifndef REP_N2
#define REP_N2 1
#endif
#ifndef REP_GU_CHEAP
#define REP_GU_CHEAP 0
#endif
#ifndef REP_FX
#define REP_FX 1
#endif
#ifndef REP_PV
#define REP_PV 1
#endif
#ifndef REP_XP
#define REP_XP 1
#endif
#ifndef REP_DMA
#define REP_DMA 1
#endif
#ifndef REP_DA
#define REP_DA 1
#endif
#ifndef REP_NA
#define REP_NA 1
#endif
#ifndef TAIL_CVT
#define TAIL_CVT 1
#endif
#ifndef REP_OUT
#define REP_OUT 1
#endif
#ifndef REP_N1
#define REP_N1 1
#endif
#ifndef REP_BAR
#define REP_BAR 1
#endif

typedef unsigned short bf16_t;
__device__ __forceinline__ float bf2f(bf16_t v) { return __uint_as_float(((unsigned)v) << 16); }
typedef float f2bf_v2f_t __attribute__((ext_vector_type(2)));
typedef __bf16 f2bf_v2b_t __attribute__((ext_vector_type(2)));
__device__ __forceinline__ bf16_t f2bf(float f) { const f2bf_v2f_t v = {f, f}; const f2bf_v2b_t b = __builtin_convertvector(v, f2bf_v2b_t); return (bf16_t)(__builtin_bit_cast(unsigned, b) & 0xffffu); }
__device__ __forceinline__ float4 ldx4(const bf16_t* p) { const uint2 u = *(const uint2*)p; return make_float4(__uint_as_float(u.x << 16), __uint_as_float(u.x & 0xffff0000u), __uint_as_float(u.y << 16), __uint_as_float(u.y & 0xffff0000u)); }

constexpr int D = 1024, NB = 8, SEQ = 2048, CTX = 256, TX = NB * SEQ, TY = NB * CTX, T = TX + TY, DEPTH = 4;
constexpr int NMOD = 6 * D, INC = 6656, NEXP = 32, CAP = T;
constexpr float EPS = 1e-6f;
constexpr float QSCALE = 0.125f * 1.4426950408889634f;

constexpr size_t al256c(size_t v) { return (v + 255) & ~(size_t)255; }
constexpr size_t OFF_CTL = 0, SZ_CTL = 65536;
constexpr size_t OFF_X = al256c(OFF_CTL + SZ_CTL);
constexpr size_t OFF_MOD = al256c(OFF_X + (size_t)T * D * 4);
constexpr size_t OFF_LAM = al256c(OFF_MOD + (size_t)DEPTH * 9 * NMOD * 4);
constexpr size_t OFF_ROPE = al256c(OFF_LAM + 256);
constexpr size_t OFF_H1 = al256c(OFF_ROPE + (size_t)2 * SEQ * 32 * 4);
constexpr size_t OFF_QKV = al256c(OFF_H1 + (size_t)T * D * 2);
constexpr size_t OFF_G = al256c(OFF_QKV + (size_t)T * 3072 * 2);
constexpr size_t OFF_FTX = al256c(OFF_G + (size_t)T * 3072 * 2);
constexpr size_t OFF_FTY = al256c(OFF_FTX + (size_t)NB * 512 * 4096 * 2);
constexpr size_t OFF_CSX = al256c(OFF_FTY + (size_t)NB * 512 * 512 * 2);
constexpr size_t OFF_CSY = al256c(OFF_CSX + (size_t)2048 * 4096 * 2);
constexpr size_t OFF_O = al256c(OFF_CSY + (size_t)256 * 512 * 2);
constexpr size_t OFF_MF = al256c(OFF_O + (size_t)T * 1536 * 2);
constexpr size_t OFF_MG = al256c(OFF_MF + (size_t)T * D * 4);
constexpr size_t OFF_ROWIDX = al256c(OFF_MG + (size_t)T * D * 2);
constexpr size_t OFF_SROWW = al256c(OFF_ROWIDX + (size_t)T * 4 * 4);
constexpr size_t OFF_H2S = al256c(OFF_SROWW + (size_t)NEXP * CAP * 4);
constexpr size_t OFF_ACT = al256c(OFF_H2S + (size_t)NEXP * CAP * D * 2);
constexpr size_t OFF_WINT = al256c(OFF_ACT + (size_t)NEXP * CAP * D * 2);
constexpr size_t OFF_WBT = al256c(OFF_WINT + (size_t)DEPTH * 7168 * D * 2);
constexpr size_t OFF_WOT = al256c(OFF_WBT + (size_t)DEPTH * 3 * D * 512 * 2);
constexpr size_t OFF_WGUT = al256c(OFF_WOT + (size_t)DEPTH * D * D * 2);
constexpr size_t OFF_WDT = al256c(OFF_WGUT + (size_t)DEPTH * NEXP * 2048 * D * 2);
constexpr size_t OFF_WF = al256c(OFF_WDT + (size_t)DEPTH * NEXP * D * D * 2);
constexpr size_t OFF_DFTC = al256c(OFF_WF + (size_t)DEPTH * D * 512 * 2);
constexpr size_t OFF_WRH = al256c(OFF_DFTC + (size_t)1024 * 512 * 2);
constexpr size_t OFF_WRL = al256c(OFF_WRH + (size_t)DEPTH * NEXP * D * 2);
constexpr size_t OFF_LIST = al256c(OFF_WRL + (size_t)DEPTH * NEXP * D * 2);
constexpr size_t WS_NEED = al256c(OFF_LIST + (size_t)NEXP * CAP * 4);
struct P {
    const float *x, *c, *ctx, *c_ctx, *w_mod, *b_mod, *nmg, *nfg, *w_in, *da_lambda, *da_subln_g, *na_rpb, *w_branch, *w_out, *w_router, *b_router, *w_gu, *b_gu, *w_dn, *b_dn, *final_g;
    float* out; char* ws;
#define WSF(name, type, off) __device__ __forceinline__ type* name() const { return (type*)(ws + (off)); }
    WSF(X, bf16_t, OFF_X) WSF(MOD, float, OFF_MOD) WSF(LAM, float, OFF_LAM) WSF(Mf, float, OFF_MF) WSF(ROPE, float, OFF_ROPE) WSF(SROWW, float, OFF_SROWW)
    WSF(H1, bf16_t, OFF_H1) WSF(QKV, bf16_t, OFF_QKV) WSF(G, unsigned char, OFF_G) WSF(FtX, bf16_t, OFF_FTX) WSF(FtY, bf16_t, OFF_FTY) WSF(CSX, bf16_t, OFF_CSX) WSF(CSY, bf16_t, OFF_CSY)
    WSF(O, bf16_t, OFF_O) WSF(Mg, bf16_t, OFF_MG) WSF(H2S, bf16_t, OFF_H2S) WSF(ACT, bf16_t, OFF_ACT) WSF(YS, bf16_t, OFF_H2S)
    WSF(WinT, bf16_t, OFF_WINT) WSF(WbT, bf16_t, OFF_WBT) WSF(WoT, bf16_t, OFF_WOT) WSF(WguT, bf16_t, OFF_WGUT) WSF(WdT, bf16_t, OFF_WDT) WSF(Wf, bf16_t, OFF_WF) WSF(DFTC, bf16_t, OFF_DFTC) WSF(WrH, bf16_t, OFF_WRH) WSF(WrL, bf16_t, OFF_WRL) WSF(LIST, int, OFF_LIST)
    WSF(CNT, int, OFF_CTL) WSF(QCTR, int, OFF_CTL + 1024) WSF(XQ, int, OFF_CTL + 32768) WSF(SIG, int, OFF_CTL + 2048) WSF(ROWIDX, int, OFF_ROWIDX) WSF(bar, unsigned, OFF_CTL + 8192)
#undef WSF
};

__device__ __forceinline__ int otid() { int t = threadIdx.x; asm volatile("" : "+v"(t)); return t; }
typedef unsigned dpp_u32x2_t __attribute__((ext_vector_type(2)));
template <int CTRL> __device__ __forceinline__ float dppf(float v) { return __uint_as_float((unsigned)__builtin_amdgcn_update_dpp(0, (int)__float_as_uint(v), CTRL, 0xf, 0xf, false)); }
template <int CTRL> __device__ __forceinline__ int dppi(int v) { return __builtin_amdgcn_update_dpp(0, v, CTRL, 0xf, 0xf, false); }
__device__ __forceinline__ float wave_sum(float v) {
    v += dppf<0xB1>(v); v += dppf<0x4E>(v); v += dppf<0x141>(v); v += dppf<0x140>(v);
    { const dpp_u32x2_t r = __builtin_amdgcn_permlane16_swap(__float_as_uint(v), __float_as_uint(v), false, false); v = __uint_as_float(r.x) + __uint_as_float(r.y); }
    { const dpp_u32x2_t r = __builtin_amdgcn_permlane32_swap(__float_as_uint(v), __float_as_uint(v), false, false); v = __uint_as_float(r.x) + __uint_as_float(r.y); }
    return v; }
__device__ __forceinline__ int modidx(int row) { return row < TX ? row / SEQ : NB; }

#define LAS __attribute__((address_space(3)))
typedef short bf16x8 __attribute__((ext_vector_type(8)));
typedef float f32x4 __attribute__((ext_vector_type(4)));
typedef unsigned u32x4 __attribute__((ext_vector_type(4)));
constexpr int BM = 256, BK = 64, HALF = 128, HTB = HALF * BK * 2, STAGE_BYTES = 8 * HTB, NXCD = 8, WGM = 8;
constexpr int LDS_SCRATCH = STAGE_BYTES, LDS_TOTAL = STAGE_BYTES + 16384 + 2048;
extern __shared__ __attribute__((aligned(16))) unsigned char dyn_smem[];
__device__ __forceinline__ int lds_byte(int r, int c) { const int st = (r >> 4) * 2 + (c >> 5), rr = r & 15, cc = c & 31, ob = rr * 64 + cc * 2; return st * 1024 + (ob ^ (((ob >> 9) & 1) << 5)); }
__device__ __forceinline__ void stage_rc(int b, int& R, int& C) { const int st = b / 1024, sb = b % 1024, swz = sb ^ (((sb >> 9) & 1) << 5); R = (st >> 1) * 16 + swz / 64; C = (st & 1) * 32 + (swz % 64) / 2; }
__device__ __forceinline__ int perm32(int rho) { const int n = rho >> 4, i = rho & 15; return 8 * (i >> 2) + 4 * n + (i & 3); }
typedef float f32x2_t __attribute__((ext_vector_type(2)));
typedef unsigned u32x2_t __attribute__((ext_vector_type(2)));
typedef __bf16 bf16x2_t __attribute__((ext_vector_type(2)));
__device__ __forceinline__ unsigned cvt_pk_bf16(float lo, float hi) { const f32x2_t v = {lo, hi}; const bf16x2_t b = __builtin_convertvector(v, bf16x2_t); return __builtin_bit_cast(unsigned, b); }
__device__ __forceinline__ unsigned sig255_(float v) { return (unsigned)__builtin_amdgcn_rcpf(__builtin_fmaf(__builtin_amdgcn_exp2f(v * -1.4426950408889634f), 1.f / 255.f, 1.f / 255.f)); }
__device__ __forceinline__ float sigmoidf_(float v) { return __builtin_amdgcn_rcpf(1.f + __builtin_amdgcn_exp2f(v * -1.4426950408889634f)); }

struct GUnit { const char *a0, *a1, *b0, *b1; int pm, pn, e, pad; };
constexpr int PRE_SLOT = 8 * 768;
__device__ __forceinline__ bool static_tile(int L, int nM, int nN, int& pm, int& pn) {
    const int nwg = nM * nN; if (L >= nwg) return false;
    int wgid = L; { const int q = nwg / NXCD, r = nwg % NXCD, xcd = wgid % NXCD, off = wgid / NXCD; wgid = (xcd < r ? xcd * (q + 1) : r * (q + 1) + (xcd - r) * q) + off; }
    const int nig = WGM * nN, gid = wgid / nig, fm = gid * WGM, gsz = (nM - fm) < WGM ? (nM - fm) : WGM;
    pm = fm + ((wgid % nig) % gsz); pn = (wgid % nig) / gsz; return true;
}

template <class G>
__device__ __forceinline__ void gemm_phase(LAS unsigned char* lds, const G& g) {
    const int tid = otid(), wid = __builtin_amdgcn_readfirstlane(tid >> 6), lane = tid & 63, wr = wid >> 2, wc = wid & 3, fr = lane & 15, fq = lane >> 4;
    const int nt = g.K / BK;
    unsigned voffA[2], voffB[2]; int stR[2], stC2[2];
#pragma unroll
    for (int i = 0; i < 2; ++i) { int R, C; stage_rc(tid * 16 + i * 8192, R, C); const int Rb = G::PERM ? ((R & ~31) + perm32(R & 31)) : R; stR[i] = R; stC2[i] = C * 2;
        voffA[i] = (unsigned)(R * g.lda + C) * 2u; voffB[i] = (unsigned)(Rb * g.ldb + C) * 2u; }
    unsigned vc0[2] = {voffA[0], voffA[1]}, vc1[2] = {voffA[0], voffA[1]}, vn0[2] = {voffA[0], voffA[1]}, vn1[2] = {voffA[0], voffA[1]};
    const size_t kstep = (size_t)(BK * 2);
    const unsigned ldsw = (unsigned)wid * 1024u;
    const int aoff = lds_byte(wr * 64 + fr, fq * 8), boff = lds_byte(wc * 32 + fr, fq * 8);
#define PG8_SA(b, h) (((b) * 2 + (h)) * HTB)
#define PG8_SB(b, h) ((4 + (b) * 2 + (h)) * HTB)
#define PG8_STAGE(bufoff, gbase, voff) do { _Pragma("unroll") for (int _i = 0; _i < 2; ++_i) \
        __builtin_amdgcn_global_load_lds((const unsigned*)((const char*)(gbase) + (voff)[_i]), (LAS unsigned*)(lds + (bufoff) + ldsw + _i * 8192), 16, 0, 0); } while (0)
#define PG8_LDA(dst, b, h) do { _Pragma("unroll") for (int m = 0; m < 4; ++m) _Pragma("unroll") for (int k = 0; k < 2; ++k) dst[m][k] = *(const LAS bf16x8*)(lds + PG8_SA(b, h) + aoff + m * 2048 + k * 1024); } while (0)
#define PG8_LDB(dst, b, h) do { _Pragma("unroll") for (int n = 0; n < 2; ++n) _Pragma("unroll") for (int k = 0; k < 2; ++k) dst[n][k] = *(const LAS bf16x8*)(lds + PG8_SB(b, h) + boff + n * 2048 + k * 1024); } while (0)
#define PG8_MMA(ai, bj, At, Bt) do { __builtin_amdgcn_s_setprio(1); _Pragma("unroll") for (int m = 0; m < 4; ++m) _Pragma("unroll") for (int n = 0; n < 2; ++n) _Pragma("unroll") for (int k = 0; k < 2; ++k) \
        acc[ai][bj][m][n] = __builtin_amdgcn_mfma_f32_16x16x32_bf16(Bt[n][k], At[m][k], acc[ai][bj][m][n], 0, 0, 0); __builtin_amdgcn_s_setprio(0); } while (0)
#define PG8_WAIT_V(n) asm volatile("s_waitcnt vmcnt(" #n ")" ::: "memory")
#define PG8_WAIT_L(n) asm volatile("s_waitcnt lgkmcnt(" #n ")" ::: "memory")
#define PG8_BAR __builtin_amdgcn_s_barrier()
#define PG8_SCHED __builtin_amdgcn_sched_barrier(0)
    GUnit cur, nxt; int ui = 0;
    if (!g.next(0, cur)) return;
    if constexpr (G::GATHER) g.gather(cur, stR, stC2, vc0, vc1);
    if constexpr (G::PRE) g.pre(cur, lds, wid, lane, 0);
    f32x4 acc[2][2][4][2];
#pragma unroll
    for (int a = 0; a < 2; ++a)
#pragma unroll
        for (int b = 0; b < 2; ++b)
#pragma unroll
            for (int m = 0; m < 4; ++m)
#pragma unroll
                for (int n = 0; n < 2; ++n) acc[a][b][m][n] = (f32x4){0.f, 0.f, 0.f, 0.f};
    bf16x8 At[4][2], B0[2][2], B1[2][2];
    PG8_STAGE(PG8_SB(0, 0), cur.b0, voffB); PG8_STAGE(PG8_SB(0, 1), cur.b1, voffB); PG8_STAGE(PG8_SA(0, 0), cur.a0, vc0); PG8_STAGE(PG8_SA(0, 1), cur.a1, vc1);
    if (wr == 1) PG8_BAR;
    PG8_WAIT_V(2); PG8_BAR;
    PG8_STAGE(PG8_SB(1, 0), cur.b0 + kstep, voffB); PG8_STAGE(PG8_SA(1, 0), cur.a0 + kstep, vc0); PG8_STAGE(PG8_SB(1, 1), cur.b1 + kstep, voffB);
    PG8_WAIT_V(6); PG8_BAR;
    if constexpr (G::PRE) g.binit(acc, lds, wid, fq, 0);
    for (;;) {
        const bool has_next = g.next(ui + 1, nxt);
        if (!has_next) nxt = cur;
        if constexpr (G::PRE) { if (has_next) g.pre(nxt, lds, wid, lane, (ui + 1) & 1); }
        if constexpr (G::GATHER) { if (has_next) g.gather(nxt, stR, stC2, vn0, vn1); else { vn0[0] = vc0[0]; vn0[1] = vc0[1]; vn1[0] = vc1[0]; vn1[1] = vc1[1]; } }
        for (int t = 0; t < nt; t += 2) {
            const bool last = (t == nt - 2);
            unsigned va0[2], va1[2];
            if constexpr (G::GATHER) { va0[0] = last ? vn0[0] : vc0[0]; va0[1] = last ? vn0[1] : vc0[1]; va1[0] = last ? vn1[0] : vc1[0]; va1[1] = last ? vn1[1] : vc1[1]; }
            else { va0[0] = voffA[0]; va0[1] = voffA[1]; va1[0] = voffA[0]; va1[1] = voffA[1]; }
            const char* a1h1 = cur.a1 + (size_t)(t + 1) * kstep;
            const char* a2_0 = last ? nxt.a0 : cur.a0 + (size_t)(t + 2) * kstep; const char* a2_1 = last ? nxt.a1 : cur.a1 + (size_t)(t + 2) * kstep;
            const char* b2_0 = last ? nxt.b0 : cur.b0 + (size_t)(t + 2) * kstep; const char* b2_1 = last ? nxt.b1 : cur.b1 + (size_t)(t + 2) * kstep;
            PG8_LDB(B0, 0, 0); PG8_LDB(B1, 0, 1); PG8_SCHED; PG8_LDA(At, 0, 0); PG8_STAGE(PG8_SA(1, 1), a1h1, vc1);
            PG8_WAIT_V(8); PG8_WAIT_L(0); PG8_BAR; PG8_MMA(0, 0, At, B0); PG8_MMA(0, 1, At, B1); PG8_BAR; PG8_SCHED;
            PG8_LDA(At, 0, 1); PG8_STAGE(PG8_SB(0, 0), b2_0, voffB); PG8_STAGE(PG8_SB(0, 1), b2_1, voffB); PG8_STAGE(PG8_SA(0, 0), a2_0, va0);
            PG8_WAIT_V(8); PG8_WAIT_L(0); PG8_BAR; PG8_MMA(1, 0, At, B0); PG8_MMA(1, 1, At, B1); PG8_BAR; PG8_SCHED;
            PG8_LDB(B0, 1, 0); PG8_LDB(B1, 1, 1); PG8_SCHED; PG8_LDA(At, 1, 0); PG8_STAGE(PG8_SA(0, 1), a2_1, va1);
            PG8_WAIT_V(8); PG8_WAIT_L(0); PG8_BAR; PG8_MMA(0, 0, At, B0); PG8_MMA(0, 1, At, B1); PG8_BAR; PG8_SCHED;
            PG8_LDA(At, 1, 1); PG8_STAGE(PG8_SB(1, 0), b2_0 + kstep, voffB); PG8_STAGE(PG8_SB(1, 1), b2_1 + kstep, voffB); PG8_STAGE(PG8_SA(1, 0), a2_0 + kstep, va0);
            PG8_WAIT_V(8); PG8_WAIT_L(0); PG8_BAR; PG8_MMA(1, 0, At, B0); PG8_MMA(1, 1, At, B1); PG8_BAR; PG8_SCHED;
        }
        if (wr == 0) PG8_BAR;
        bool keep; if constexpr (G::PRE) keep = g.epi(acc, cur, wr, wc, fr, fq, ui & 1); else keep = g.epi(acc, cur, wr, wc, fr, fq);
        if (!has_next) break;
        if constexpr (G::PRE) g.binit(acc, lds, wid, fq, (ui + 1) & 1);
        else if (!keep)
#pragma unroll
        for (int a = 0; a < 2; ++a)
#pragma unroll
            for (int b = 0; b < 2; ++b)
#pragma unroll
                for (int m = 0; m < 4; ++m)
#pragma unroll
                    for (int n = 0; n < 2; ++n) acc[a][b][m][n] = (f32x4){0.f, 0.f, 0.f, 0.f};
        cur = nxt; ++ui;
        if constexpr (G::GATHER) { vc0[0] = vn0[0]; vc0[1] = vn0[1]; vc1[0] = vn1[0]; vc1[1] = vn1[1]; }
        if (wr == 1) PG8_BAR;
    }
    PG8_WAIT_V(0);
    PG8_BAR;
#undef PG8_SA
#undef PG8_SB
#undef PG8_STAGE
#undef PG8_LDA
#undef PG8_LDB
#undef PG8_MMA
#undef PG8_WAIT_V
#undef PG8_WAIT_L
#undef PG8_BAR
#undef PG8_SCHED
}

struct GInproj {
    static constexpr bool PERM = true, GATHER = false, PRE = false;
    P p; int l, lda, ldb, K, G, c;
    __device__ __forceinline__ bool next(int i, GUnit& u) const {
        int pm, pn; if (!static_tile(i * G + c, T / 256, 28, pm, pn)) return false;
        u.pm = pm; u.pn = pn; u.e = 0; u.pad = 0;
        u.a0 = (const char*)(p.H1() + (size_t)pm * 256 * D); u.a1 = u.a0 + (size_t)HALF * D * 2;
        u.b0 = (const char*)(p.WinT() + ((size_t)l * 7168 + pn * 256) * D); u.b1 = u.b0 + (size_t)HALF * D * 2; return true; }
    __device__ __forceinline__ bool epi(f32x4 (&acc)[2][2][4][2], const GUnit& u, int wr, int wc, int fr, int fq) const {
        const int row0 = u.pm * 256 + wr * 64 + fr, pn = u.pn;
        if (pn < 12) {
            const bool rope = (pn < 4) && (u.pm < TX / 256);
            const float qs = (pn < 2 || pn == 6 || pn == 7) ? QSCALE : 1.f;
            const int axis = wc & 1, i0 = 8 * (fq & 1); const float sg = (fq >> 1) ? 1.f : -1.f;
#pragma unroll
            for (int ai = 0; ai < 2; ++ai) {
                f32x4 tc[4][4];
                if (rope) {
#pragma unroll
                    for (int m = 0; m < 4; ++m) { const int s_ = (row0 + ai * HALF + m * 16) & (SEQ - 1); const float* ct = p.ROPE() + s_ * 32 + axis * 16 + i0; const float* st = ct + SEQ * 32;
                        tc[m][0] = *(const f32x4*)ct; tc[m][1] = *(const f32x4*)(ct + 4); tc[m][2] = *(const f32x4*)st; tc[m][3] = *(const f32x4*)(st + 4); } }
#pragma unroll
                for (int m = 0; m < 4; ++m) { const int row = row0 + ai * HALF + m * 16;
#pragma unroll
                    for (int bj = 0; bj < 2; ++bj) { f32x4 v0 = acc[ai][bj][m][0] * qs, v1 = acc[ai][bj][m][1] * qs; const int col0 = pn * 256 + bj * HALF + wc * 32 + 8 * fq;
                        if (rope) { f32x4 q0, q1;
#pragma unroll
                            for (int j = 0; j < 4; ++j) { q0[j] = __shfl_xor(v0[j], 32); q1[j] = __shfl_xor(v1[j], 32); }
                            v0 = v0 * tc[m][0] + sg * (q0 * tc[m][2]); v1 = v1 * tc[m][1] + sg * (q1 * tc[m][3]); }
                        u32x4 w; w.x = cvt_pk_bf16(v0[0], v0[1]); w.y = cvt_pk_bf16(v0[2], v0[3]); w.z = cvt_pk_bf16(v1[0], v1[1]); w.w = cvt_pk_bf16(v1[2], v1[3]);
                        *(u32x4*)(p.QKV() + (size_t)row * 3072 + col0) = w; } } }
        } else if (pn < 16) {
            LAS bf16_t* stg = (LAS bf16_t*)((LAS unsigned char*)dyn_smem + LDS_SCRATCH) + (wr * 4 + wc) * 1024;
            const int lane = fq * 16 + fr; const bool isx = u.pm < TX / 256;
            const int wofs = ((4 * fq) * 8 + (fr & 7)) * 8 + (fr >> 3);
#pragma unroll
            for (int ai = 0; ai < 2; ++ai) {
                const int rowb = u.pm * 256 + ai * HALF + wr * 64;
                bf16_t* dbase; size_t cst;
                if (isx) { dbase = p.FtX() + ((size_t)(rowb >> 11) * 512 * 8 + (lane & 7)) * 512 + ((rowb & (SEQ - 1)) >> 3); cst = 8 * 512; }
                else { dbase = p.FtY() + (size_t)((rowb - TX) >> 8) * 512 * 512 + (lane & 7) * 32 + (((rowb - TX) & (CTX - 1)) >> 3); cst = 512; }
#pragma unroll
                for (int bj = 0; bj < 2; ++bj)
#pragma unroll
                    for (int n = 0; n < 2; ++n) {
#pragma unroll
                        for (int m = 0; m < 4; ++m)
#pragma unroll
                            for (int j = 0; j < 4; ++j) stg[wofs + 64 * j + 2 * m] = f2bf(acc[ai][bj][m][n][j]);
                        __builtin_amdgcn_s_waitcnt(0xc07f);
#pragma unroll
                        for (int h2 = 0; h2 < 2; ++h2) { const int c16 = (lane >> 3) + 8 * h2;
                            const u32x4 v = *(const LAS u32x4*)(stg + (lane + 64 * h2) * 8);
                            const int cabs = (pn - 12) * 256 + bj * HALF + wc * 32 + 8 * (c16 >> 2) + 4 * n + (c16 & 3);
                            *(u32x4*)(dbase + (size_t)(cabs & 511) * cst + (cabs >> 9) * 256) = v; }
                        __builtin_amdgcn_s_waitcnt(0xc07f);
                    } }
        } else {
#pragma unroll
            for (int ai = 0; ai < 2; ++ai)
#pragma unroll
                for (int m = 0; m < 4; ++m) { const int row = row0 + ai * HALF + m * 16;
#pragma unroll
                    for (int bj = 0; bj < 2; ++bj) { const f32x4 v0 = acc[ai][bj][m][0], v1 = acc[ai][bj][m][1]; const int col0 = (pn - 16) * 256 + bj * HALF + wc * 32 + 8 * fq;
                        uint2 w; w.x = sig255_(v0[0]) | (sig255_(v0[1]) << 8) | (sig255_(v0[2]) << 16) | (sig255_(v0[3]) << 24); w.y = sig255_(v1[0]) | (sig255_(v1[1]) << 8) | (sig255_(v1[2]) << 16) | (sig255_(v1[3]) << 24);
                        *(uint2*)(p.G() + (size_t)row * 3072 + col0) = w; } }
        }
        return false;
    }
};
struct GFourX {
    static constexpr bool PERM = true, GATHER = false, PRE = false;
    P p; int lda, ldb, K, unit, pad0, pad1;
    __device__ __forceinline__ bool next(int i, GUnit& u) const {
        if (i > 0) return false; const int L = unit;
        const int b = L >> 5, t = (L >> 4) & 1, pn = L & 15; u.pm = t; u.pn = pn; u.e = b; u.pad = 0;
        u.a0 = (const char*)(p.CSX() + (size_t)t * 256 * 512); u.a1 = u.a0 + (size_t)HALF * 512 * 2;
        u.b0 = (const char*)(p.FtX() + ((size_t)b * 4096 + pn * 256) * 512); u.b1 = u.b0 + (size_t)HALF * 512 * 2; return true; }
    __device__ __forceinline__ bool epi(f32x4 (&acc)[2][2][4][2], const GUnit& u, int wr, int wc, int fr, int fq) const {
        const float RS = 0.70710678118654752f;
#pragma unroll
        for (int m = 0; m < 4; ++m) { const int k2 = 128 * u.pm + wr * 64 + m * 16 + fr;
            float cw, sw; { const float a = (float)k2 * (1.f / 2048.f); cw = __builtin_amdgcn_cosf(a); sw = __builtin_amdgcn_sinf(a); }
#pragma unroll
            for (int bj = 0; bj < 2; ++bj) { const int col = 32 * u.pn + 16 * bj + 4 * wc + fq;
                float yr[8], yi[8]; float tc = 1.f, ts = 0.f;
#pragma unroll
                for (int q = 0; q < 8; ++q) { const float re = acc[0][bj][m][q >> 2][q & 3], im = acc[1][bj][m][q >> 2][q & 3];
                    yr[q] = re * tc - im * ts; yi[q] = re * ts + im * tc; const float nc = tc * cw - ts * sw; ts = tc * sw + ts * cw; tc = nc; }
                const float a0 = yr[0] + yr[4], a1 = yr[0] - yr[4], b0 = yr[2] + yr[6], b1 = yr[2] - yr[6], c0 = yr[1] + yr[5], c1 = yr[1] - yr[5], d0 = yr[3] + yr[7], d1 = yr[3] - yr[7];
                const float e1 = yi[0] - yi[4], f0 = yi[2] + yi[6], f1 = yi[2] - yi[6], g0 = yi[1] + yi[5], g1 = yi[1] - yi[5], h0 = yi[3] + yi[7], h1 = yi[3] - yi[7];
                (void)e1; (void)f0; (void)g0; (void)h0;
                float o[8];
                o[0] = (a0 + b0) + (c0 + d0);
                o[4] = (a0 + b0) - (c0 + d0);
                o[2] = (a0 - b0) - (g0 - h0);
                o[6] = (a0 - b0) + (g0 - h0);
                o[1] = a1 + RS * (c1 - d1) - (f1 + RS * (g1 + h1));
                o[7] = a1 + RS * (c1 - d1) + (f1 + RS * (g1 + h1));
                o[3] = a1 - RS * (c1 - d1) - (RS * (g1 + h1) - f1);
                o[5] = a1 - RS * (c1 - d1) + (RS * (g1 + h1) - f1);
                unsigned pk[4];
#pragma unroll
                for (int q = 0; q < 4; ++q) { const u32x2_t r = __builtin_amdgcn_permlane16_swap(__float_as_uint(o[2 * q] * (1.f / 512.f)), __float_as_uint(o[2 * q + 1] * (1.f / 512.f)), false, false);
                    pk[q] = cvt_pk_bf16(__uint_as_float(r.x), __uint_as_float(r.y)); }
                const int par = fq & 1, up = fq >> 1;
                bf16_t* dst = p.O() + ((size_t)u.e * SEQ + k2) * 1536 + 1024 + (col - fq) + 0;
#pragma unroll
                for (int h = 0; h < 2; ++h) { const u32x2_t r = __builtin_amdgcn_permlane32_swap(pk[2 * h], pk[2 * h + 1], false, false);
                    const int k1 = 2 * (2 * h + up) + par;
                    *(uint2*)(dst + (size_t)k1 * 256 * 1536) = make_uint2(r.x, r.y); } } }
        return false;
    }
};
struct GFourY {
    static constexpr bool PERM = true, GATHER = false, PRE = false;
    P p; int lda, ldb, K, unit, pad0, pad1;
    __device__ __forceinline__ bool next(int i, GUnit& u) const {
        if (i > 0) return false; const int L = unit;
        const int b = L >> 1, pn = L & 1; u.pm = 0; u.pn = pn; u.e = b; u.pad = 0;
        u.a0 = (const char*)p.CSY(); u.a1 = u.a0 + (size_t)HALF * 512 * 2;
        u.b0 = (const char*)(p.FtY() + ((size_t)b * 512 + pn * 256) * 512); u.b1 = u.b0 + (size_t)HALF * 512 * 2; return true; }
    __device__ __forceinline__ bool epi(f32x4 (&acc)[2][2][4][2], const GUnit& u, int wr, int wc, int fr, int fq) const {
        const int row0 = TX + u.e * CTX + wr * 64 + fr;
#pragma unroll
        for (int ai = 0; ai < 2; ++ai)
#pragma unroll
            for (int m = 0; m < 4; ++m) { const int row = row0 + ai * HALF + m * 16;
#pragma unroll
                for (int bj = 0; bj < 2; ++bj) { const f32x4 v0 = acc[ai][bj][m][0] * 0.005524271728f, v1 = acc[ai][bj][m][1] * 0.005524271728f; const int col0 = 1024 + u.pn * 256 + bj * HALF + wc * 32 + 8 * fq;
                    u32x4 w; w.x = cvt_pk_bf16(v0[0], v0[1]); w.y = cvt_pk_bf16(v0[2], v0[3]); w.z = cvt_pk_bf16(v1[0], v1[1]); w.w = cvt_pk_bf16(v1[2], v1[3]);
                    *(u32x4*)(p.O() + (size_t)row * 1536 + col0) = w; } }
        return false;
    }
};
struct GMerge {
    static constexpr bool PERM = true, GATHER = false, PRE = false;
    P p; int l, nM, lda, ldb, K, G, c, ytile;
    __device__ __forceinline__ bool next(int i, GUnit& u) const {
        const int ti = i / 3, br = i - ti * 3; int pm, pn;
        if (ytile >= 0) { if (ti > 0) return false; pm = 64 + (ytile >> 2); pn = ytile & 3; }
        else if (!static_tile(ti * G + c, nM, 4, pm, pn)) return false;
        u.pm = pm; u.pn = pn; u.e = br; u.pad = 0;
        u.a0 = (const char*)(p.O() + (size_t)pm * 256 * 1536 + br * 512); u.a1 = u.a0 + (size_t)HALF * 1536 * 2;
        u.b0 = (const char*)(p.WbT() + (((size_t)l * 3 + br) * D + pn * 256) * 512); u.b1 = u.b0 + (size_t)HALF * 512 * 2; return true; }
    __device__ __forceinline__ bool epi(f32x4 (&acc)[2][2][4][2], const GUnit& u, int wr, int wc, int fr, int fq) const {
        const int row0 = u.pm * 256 + wr * 64 + fr, br = u.e, colb = u.pn * 256 + wc * 32 + 8 * fq;
#pragma unroll
        for (int ai = 0; ai < 2; ++ai) {
            uint2 ga[4][2], gb[4][2];
#pragma unroll
            for (int m = 0; m < 4; ++m)
#pragma unroll
                for (int bj = 0; bj < 2; ++bj) { const unsigned char* gp = p.G() + (size_t)(row0 + ai * HALF + m * 16) * 3072 + br * D + colb + bj * HALF;
                    ga[m][bj] = *(const uint2*)gp; if (br < 2) gb[m][bj] = *(const uint2*)(gp + D); }
#pragma unroll
            for (int m = 0; m < 4; ++m)
#pragma unroll
                for (int bj = 0; bj < 2; ++bj) { float f[8];
#pragma unroll
                    for (int q = 0; q < 4; ++q) { f[q] = __builtin_fmaf((float)((ga[m][bj].x >> (8 * q)) & 0xffu), 1.f / 255.f, 0.5f / 255.f); f[4 + q] = __builtin_fmaf((float)((ga[m][bj].y >> (8 * q)) & 0xffu), 1.f / 255.f, 0.5f / 255.f); }
                    if (br < 2) {
#pragma unroll
                        for (int q = 0; q < 4; ++q) {
                            f[q] *= __builtin_amdgcn_rcpf(__builtin_fmaf((float)((gb[m][bj].x >> (8 * q)) & 0xffu), 1.f / 255.f, 0.5f / 255.f)); f[4 + q] *= __builtin_amdgcn_rcpf(__builtin_fmaf((float)((gb[m][bj].y >> (8 * q)) & 0xffu), 1.f / 255.f, 0.5f / 255.f)); } }
                    f32x4 v0 = acc[ai][bj][m][0], v1 = acc[ai][bj][m][1];
                    v0[0] *= f[0]; v0[1] *= f[1]; v0[2] *= f[2]; v0[3] *= f[3]; v1[0] *= f[4]; v1[1] *= f[5]; v1[2] *= f[6]; v1[3] *= f[7];
                    if (br < 2) { acc[ai][bj][m][0] = v0; acc[ai][bj][m][1] = v1; }
                    else { u32x4 w; w.x = cvt_pk_bf16(v0[0], v0[1]); w.y = cvt_pk_bf16(v0[2], v0[3]); w.z = cvt_pk_bf16(v1[0], v1[1]); w.w = cvt_pk_bf16(v1[2], v1[3]);
                        *(u32x4*)(p.Mg() + (size_t)(row0 + ai * HALF + m * 16) * D + colb + bj * HALF) = w; } } }
        return br < 2;
    }
};
struct GOut {
    static constexpr bool PERM = false, GATHER = false, PRE = false;
    P p; int l, nM, lda, ldb, K, G, c, ytile; float scale; int pad;
    __device__ __forceinline__ bool next(int i, GUnit& u) const {
        int pm, pn;
        if (ytile >= 0) { if (i > 0) return false; pm = 64 + (ytile >> 2); pn = ytile & 3; }
        else if (!static_tile(i * G + c, nM, 4, pm, pn)) return false;
        u.pm = pm; u.pn = pn; u.e = 0; u.pad = 0;
        u.a0 = (const char*)(p.Mg() + (size_t)pm * 256 * D); u.a1 = u.a0 + (size_t)HALF * D * 2;
        u.b0 = (const char*)(p.WoT() + ((size_t)l * D + pn * 256) * D); u.b1 = u.b0 + (size_t)HALF * D * 2; return true; }
    __device__ __forceinline__ bool epi(f32x4 (&acc)[2][2][4][2], const GUnit& u, int wr, int wc, int fr, int fq) const {
        const int row0 = u.pm * 256 + wr * 64 + fr, col0 = u.pn * 256 + wc * 32 + 4 * fq;
        const float* g1 = p.MOD() + (size_t)(l * 9 + modidx(u.pm * 256)) * NMOD + 2 * D;
        f32x4 gv[2][2];
#pragma unroll
        for (int bj = 0; bj < 2; ++bj)
#pragma unroll
            for (int n = 0; n < 2; ++n) gv[bj][n] = *(const f32x4*)(g1 + col0 + bj * HALF + n * 16) * scale;
#pragma unroll
        for (int ai = 0; ai < 2; ++ai) { f32x4 xv[4][2][2];
#pragma unroll
            for (int m = 0; m < 4; ++m)
#pragma unroll
                for (int bj = 0; bj < 2; ++bj)
#pragma unroll
                    for (int n = 0; n < 2; ++n) { const float4 x4 = ldx4(p.X() + (size_t)(row0 + ai * HALF + m * 16) * D + col0 + bj * HALF + n * 16); xv[m][bj][n] = (f32x4){x4.x, x4.y, x4.z, x4.w}; }
#pragma unroll
            for (int m = 0; m < 4; ++m)
#pragma unroll
                for (int bj = 0; bj < 2; ++bj)
#pragma unroll
                    for (int n = 0; n < 2; ++n) { const f32x4 r = xv[m][bj][n] + gv[bj][n] * acc[ai][bj][m][n]; uint2 w; w.x = cvt_pk_bf16(r[0], r[1]); w.y = cvt_pk_bf16(r[2], r[3]);
                        *(uint2*)(p.X() + (size_t)(row0 + ai * HALF + m * 16) * D + col0 + bj * HALF + n * 16) = w; } }
        return false;
    }
};
__device__ __forceinline__ void moe_tiles(const P& p, int l, LAS int* mtb) {
    const int t_ = otid();
    if (t_ < 64) { const int t = t_; int v = t < NEXP ? (p.CNT()[l * NEXP + t] + 255) >> 8 : 0;
        for (int o = 1; o < 32; o <<= 1) { const int u = __shfl_up(v, o); if ((t & 63) >= o) v += u; }
        if (t < NEXP) mtb[t + 1] = v; if (t == 0) mtb[0] = 0; if (t < NEXP) mtb[40 + t] = p.CNT()[l * NEXP + t]; }
    __syncthreads();
}
template <int NN>
__device__ __forceinline__ bool moe_unit(const LAS int* mtb, int i, int G, int c, int& e, int& rowbase, int& pn) {
    const int total = mtb[NEXP] * NN;
    const int L = i * G + c; if (L >= total) return false;
    const int mt = L / NN; pn = L - mt * NN; int ee = 0; while (ee < NEXP - 1 && mtb[ee + 1] <= mt) ++ee;
    e = ee; rowbase = ee * CAP + (mt - mtb[ee]) * 256; return true;
}
struct GGateUp {
    static constexpr bool PERM = true, GATHER = true, PRE = true;
    P p; const LAS int* mtb; int l, lda, ldb, K, G, c, cheap, pad;
    __device__ __forceinline__ bool next(int i, GUnit& u) const {
        int e, rb, pn; if (!moe_unit<8>(mtb, i, G, c, e, rb, pn)) return false;
        u.pm = rb; u.pn = pn; u.e = e; u.pad = mtb[40 + e] - (rb - e * CAP);
        u.a0 = (const char*)p.H1(); u.a1 = u.a0;
        const bf16_t* w = p.WguT() + ((size_t)l * NEXP + e) * 2048 * D; u.b0 = (const char*)(w + (size_t)pn * 128 * D); u.b1 = (const char*)(w + (size_t)(1024 + pn * 128) * D); return true; }
    __device__ __forceinline__ void gather(const GUnit& u, const int (&R)[2], const int (&C2)[2], unsigned (&v0)[2], unsigned (&v1)[2]) const {
        const int* li = p.LIST() + u.pm;
#pragma unroll
        for (int i = 0; i < 2; ++i) { const int t0 = (R[i] < u.pad) ? li[R[i]] : 0, t1 = (R[i] + HALF < u.pad) ? li[R[i] + HALF] : 0;
            v0[i] = (unsigned)t0 * (unsigned)(D * 2) + (unsigned)C2[i]; v1[i] = (unsigned)t1 * (unsigned)(D * 2) + (unsigned)C2[i]; } }
    __device__ __forceinline__ void pre(const GUnit& u, LAS unsigned char* lds, int wid, int lane, int sl) const {
        const float* src = p.b_gu + ((size_t)l * NEXP + u.e) * 2048 + u.pn * 128 + (wid & 3) * 32 + (lane & 31) + (lane >> 5) * 1024;
        __builtin_amdgcn_global_load_lds((const unsigned*)src, (LAS unsigned*)(lds + LDS_SCRATCH + 512 + sl * PRE_SLOT + wid * 768), 4, 0, 0); }
    __device__ __forceinline__ void binit(f32x4 (&acc)[2][2][4][2], LAS unsigned char* lds, int wid, int fq, int sl) const {
        const LAS float* bb = (const LAS float*)(lds + LDS_SCRATCH + 512 + sl * PRE_SLOT + wid * 768) + 8 * fq;
        f32x4 bg[2], bu[2];
#pragma unroll
        for (int n = 0; n < 2; ++n) { bg[n] = *(const LAS f32x4*)(bb + 4 * n); bu[n] = *(const LAS f32x4*)(bb + 32 + 4 * n); }
#pragma unroll
        for (int ai = 0; ai < 2; ++ai)
#pragma unroll
            for (int m = 0; m < 4; ++m)
#pragma unroll
                for (int n = 0; n < 2; ++n) { acc[ai][0][m][n] = bg[n]; acc[ai][1][m][n] = bu[n]; } }
    __device__ __forceinline__ bool epi(f32x4 (&acc)[2][2][4][2], const GUnit& u, int wr, int wc, int fr, int fq, int sl) const {
        if (cheap) {
#pragma unroll
            for (int a = 0; a < 2; ++a)
#pragma unroll
                for (int b = 0; b < 2; ++b)
#pragma unroll
                    for (int m = 0; m < 4; ++m)
#pragma unroll
                        for (int n = 0; n < 2; ++n) asm volatile("" :: "v"(acc[a][b][m][n]));
            return false; }
        const int row0 = u.pm + wr * 64 + fr, j0 = u.pn * 128 + wc * 32 + 8 * fq;
#pragma unroll
        for (int ai = 0; ai < 2; ++ai)
#pragma unroll
            for (int m = 0; m < 4; ++m) { const int row = row0 + ai * HALF + m * 16; float a[8];
#pragma unroll
                for (int n = 0; n < 2; ++n)
#pragma unroll
                    for (int j = 0; j < 4; ++j) { const float gate = fminf(acc[ai][0][m][n][j], 7.f), up = __builtin_amdgcn_fmed3f(acc[ai][1][m][n][j], -7.f, 7.f);
                        const float t = gate * __builtin_amdgcn_rcpf(1.f + __builtin_amdgcn_exp2f(gate * (-1.702f * 1.4426950408889634f))); a[4 * n + j] = __builtin_fmaf(up, t, t); }
                u32x4 w; w.x = cvt_pk_bf16(a[0], a[1]); w.y = cvt_pk_bf16(a[2], a[3]); w.z = cvt_pk_bf16(a[4], a[5]); w.w = cvt_pk_bf16(a[6], a[7]);
                *(u32x4*)(p.ACT() + (size_t)row * D + j0) = w; }
        return false;
    }
};
struct GDown {
    static constexpr bool PERM = true, GATHER = false, PRE = true;
    P p; const LAS int* mtb; int l, lda, ldb, K, G, c;
    __device__ __forceinline__ bool next(int i, GUnit& u) const {
        int e, rb, pn; if (!moe_unit<4>(mtb, i, G, c, e, rb, pn)) return false;
        u.pm = rb; u.pn = pn; u.e = e; u.pad = 0;
        u.a0 = (const char*)(p.ACT() + (size_t)rb * D); u.a1 = u.a0 + (size_t)HALF * D * 2;
        u.b0 = (const char*)(p.WdT() + (((size_t)l * NEXP + e) * D + pn * 256) * D); u.b1 = u.b0 + (size_t)HALF * D * 2; return true; }
    __device__ __forceinline__ void pre(const GUnit& u, LAS unsigned char* lds, int wid, int lane, int slt) const {
        LAS unsigned char* sl = lds + LDS_SCRATCH + 512 + slt * PRE_SLOT + wid * 768;
        const float* bs = p.b_dn + ((size_t)l * NEXP + u.e) * D + u.pn * 256 + (wid & 3) * 32 + (lane & 31) + (lane >> 5) * HALF;
        const float* rs = p.SROWW() + u.pm + (wid >> 2) * 64 + lane;
        __builtin_amdgcn_global_load_lds((const unsigned*)bs, (LAS unsigned*)sl, 4, 0, 0);
        __builtin_amdgcn_global_load_lds((const unsigned*)rs, (LAS unsigned*)(sl + 256), 4, 0, 0);
        __builtin_amdgcn_global_load_lds((const unsigned*)(rs + HALF), (LAS unsigned*)(sl + 512), 4, 0, 0); }
    __device__ __forceinline__ void binit(f32x4 (&acc)[2][2][4][2], LAS unsigned char* lds, int wid, int fq, int slt) const {
        const LAS float* sl = (const LAS float*)(lds + LDS_SCRATCH + 512 + slt * PRE_SLOT + wid * 768);
#pragma unroll
        for (int bj = 0; bj < 2; ++bj)
#pragma unroll
            for (int n = 0; n < 2; ++n) { const f32x4 b = *(const LAS f32x4*)(sl + bj * 32 + 8 * fq + 4 * n);
#pragma unroll
                for (int ai = 0; ai < 2; ++ai)
#pragma unroll
                    for (int m = 0; m < 4; ++m) acc[ai][bj][m][n] = b; } }
    __device__ __forceinline__ bool epi(f32x4 (&acc)[2][2][4][2], const GUnit& u, int wr, int wc, int fr, int fq, int slt) const {
        const int row0 = u.pm + wr * 64 + fr, colb = u.pn * 256 + wc * 32 + 8 * fq;
        const LAS float* sl = (const LAS float*)((const LAS unsigned char*)dyn_smem + LDS_SCRATCH + 512 + slt * PRE_SLOT + (wr * 4 + wc) * 768);
        float rws[2][4];
#pragma unroll
        for (int ai = 0; ai < 2; ++ai)
#pragma unroll
            for (int m = 0; m < 4; ++m) rws[ai][m] = sl[64 + ai * 64 + m * 16 + fr];
#pragma unroll
        for (int ai = 0; ai < 2; ++ai)
#pragma unroll
            for (int m = 0; m < 4; ++m) { const int row = row0 + ai * HALF + m * 16; const float rw = rws[ai][m];
#pragma unroll
                for (int bj = 0; bj < 2; ++bj) { const f32x4 v0 = acc[ai][bj][m][0] * rw, v1 = acc[ai][bj][m][1] * rw;
                    u32x4 w; w.x = cvt_pk_bf16(v0[0], v0[1]); w.y = cvt_pk_bf16(v0[2], v0[3]); w.z = cvt_pk_bf16(v1[0], v1[1]); w.w = cvt_pk_bf16(v1[2], v1[3]);
                    *(u32x4*)(p.YS() + (size_t)row * D + colb + bj * HALF) = w; } }
        return false;
    }
};
typedef float f32x16 __attribute__((ext_vector_type(16)));
typedef short s16x4 __attribute__((ext_vector_type(4)));
__device__ __forceinline__ int crow(int r, int hi) { return (r & 3) + 8 * (r >> 2) + 4 * hi; }
__device__ __forceinline__ s16x4 vtr(const LAS unsigned char* q) { return __builtin_bit_cast(s16x4, __builtin_amdgcn_ds_read_tr16_b64_v4i16((LAS s16x4*)q)); }
constexpr int AT_WSF = 139264, AT_TAB = AT_WSF + 2048, AT_X1 = 73728;
#define SQ_SB __builtin_amdgcn_sched_barrier(0)
#define SQ_VTR(dst, addr, off) asm volatile("ds_read_b64_tr_b16 %0, %1 offset:%2" : "=v"(dst) : "v"(addr), "n"(off) : "memory")
#define SQ_VW(n, f0, f1, f2, f3) asm volatile("s_waitcnt lgkmcnt(" #n ")" : "+v"(f0), "+v"(f1), "+v"(f2), "+v"(f3) :: "memory")
template <int MODE>
__device__ __forceinline__ void attn_unit_seq(const P& p, int l, LAS unsigned char* lds, int h, int qrow0, int kb0, int n0, int kb1, int n1, int R0, int j0) {
    constexpr int DV = MODE == 0 ? 128 : 64, ND = DV / 32, KB = MODE == 0 ? 16384 : 8192, VB = DV * 64 * 2, SLOT = KB + VB;
    const int tid = otid(), lane = tid & 63, r32 = lane & 31, hi = lane >> 5, wid = __builtin_amdgcn_readfirstlane(tid >> 6);
    const int msub = MODE == 0 ? (wid >> 2) : 0;
    const int qbase = qrow0 + (MODE == 0 ? 32 * (wid & 3) : 32 * wid);
    const int qcol = MODE == 0 ? h * 128 + msub * 64 : 1536 + h * 64;
    const int kcol = MODE == 0 ? 512 + h * 128 : 2048 + h * 64;
    const int vcol = MODE == 0 ? 1024 + h * 128 : 2560 + h * 64;
    const int rp = wid >> 2, g = wid & 3, ks0 = min(max(16 * g - 8, 0), 32);
    int qtok = qbase + r32, rq = 0, rs_q = 0, qc = 0, cs = 0, rsA = 0, rsB = 0;
    if (MODE == 1) { rq = R0 + 2 * rp + (r32 >> 4); qc = 16 * g + (r32 & 15); qtok = qrow0 + (2 * rp + (r32 >> 4)) * 64 + qc;
        rs_q = min(max(rq - 4, 0), 24); cs = min(max(qc - 8, 0), 48); rsA = min(max(R0 + 2 * rp - 4, 0), 24); rsB = min(max(R0 + 2 * rp - 3, 0), 24); }
    bf16x8 qr[4];
#pragma unroll
    for (int d0 = 0; d0 < 4; ++d0) qr[d0] = *(const bf16x8*)(p.QKV() + (size_t)qtok * 3072 + qcol + d0 * 16 + hi * 8);
    LAS float* wsf = (LAS float*)(lds + AT_WSF + wid * 256);
    LAS float* tab = (LAS float*)(lds + AT_TAB);
    if (MODE == 1) { for (int i = tid; i < 768; i += 512) { const int idx = i - 64; float v = 0.f;
            if (idx >= 0 && idx < 480) { const int dr = idx >> 5, dc = idx & 31; if (dc < 31) v = p.na_rpb[((size_t)(l * 8 + h) * 15 + dr) * 31 + dc] * 1.4426950408889634f; }
            tab[i] = v; } }
    const int NT = n0 + n1;
    auto issueK = [&](int t, int s) {
        const int tb = t < n0 ? kb0 + 64 * t : kb1 + 64 * (t - n0); LAS unsigned char* slot = lds + s * KB;
        if (MODE == 0) {
#pragma unroll
            for (int i = 0; i < 2; ++i) { const int id = wid * 2 + i;
                __builtin_amdgcn_global_load_lds((const unsigned*)(p.QKV() + (size_t)(tb + 8 * (id & 7) + (lane & 7)) * 3072 + kcol + (id >> 3) * 64 + ((lane >> 3) ^ (id & 1)) * 8), (LAS unsigned*)(slot + (id >> 3) * 8192 + (id & 7) * 1024), 16, 0, 0); }
        } else __builtin_amdgcn_global_load_lds((const unsigned*)(p.QKV() + (size_t)(tb + 8 * wid + (lane & 7)) * 3072 + kcol + ((lane >> 3) ^ (wid & 1)) * 8), (LAS unsigned*)(slot + wid * 1024), 16, 0, 0);
    };
    auto issueV = [&](int t, int s) {
        const int tb = t < n0 ? kb0 + 64 * t : kb1 + 64 * (t - n0); LAS unsigned char* slot = lds + 4 * KB + s * VB;
        if (MODE == 0) {
#pragma unroll
            for (int i = 0; i < 2; ++i) { const int id = wid * 2 + i;
                __builtin_amdgcn_global_load_lds((const unsigned*)(p.QKV() + (size_t)(tb + 16 * (id & 3) + (lane >> 2)) * 3072 + vcol + 32 * (id >> 2) + (lane & 3) * 8), (LAS unsigned*)(slot + (id >> 2) * 4096 + (id & 3) * 1024), 16, 0, 0); }
        } else __builtin_amdgcn_global_load_lds((const unsigned*)(p.QKV() + (size_t)(tb + 16 * (wid & 3) + (lane >> 2)) * 3072 + vcol + 32 * (wid >> 2) + (lane & 3) * 8), (LAS unsigned*)(slot + (wid >> 2) * 4096 + (wid & 3) * 1024), 16, 0, 0);
    };
    auto tile_act = [&](int t) -> bool { if (MODE != 1 || t >= n0) return true; const int j = j0 + t; return (j >= rsA) && (j < rsB + 8); };
    auto qk = [&](int t, f32x16& a0, f32x16& a1, float init) {
        if (MODE == 1 && t < n0) {
            const int kb_ = (ks0 + r32) >> 3; const LAS unsigned char* kp = lds + (t & 3) * KB + kb_ * 1024 + (r32 & 7) * 16 + ((hi ^ (kb_ & 1)) * 128);
#pragma unroll
            for (int r = 0; r < 16; ++r) a0[r] = init;
#pragma unroll
            for (int d0 = 0; d0 < 4; ++d0) { const bf16x8 b0 = *(const LAS bf16x8*)(kp + d0 * 256); a0 = __builtin_amdgcn_mfma_f32_32x32x16_bf16(b0, qr[d0], a0, 0, 0, 0); }
        } else {
            const LAS unsigned char* kp = lds + (t & 3) * KB + msub * 8192 + (r32 >> 3) * 1024 + (r32 & 7) * 16 + ((hi ^ ((r32 >> 3) & 1)) * 128);
#pragma unroll
            for (int r = 0; r < 16; ++r) { a0[r] = init; a1[r] = init; }
#pragma unroll
            for (int d0 = 0; d0 < 4; ++d0) { const bf16x8 b0 = *(const LAS bf16x8*)(kp + d0 * 256), b1 = *(const LAS bf16x8*)(kp + d0 * 256 + 4096);
                a0 = __builtin_amdgcn_mfma_f32_32x32x16_bf16(b0, qr[d0], a0, 0, 0, 0); a1 = __builtin_amdgcn_mfma_f32_32x32x16_bf16(b1, qr[d0], a1, 0, 0, 0); }
        }
    };
    f32x16 o[ND];
#pragma unroll
    for (int d0 = 0; d0 < ND; ++d0)
#pragma unroll
        for (int r = 0; r < 16; ++r) o[d0][r] = 0.f;
    float mref = 0.f;
    f32x16 osum;
#pragma unroll
    for (int r = 0; r < 16; ++r) osum[r] = 0.f;
    const bf16x8 ones = (bf16x8){16256, 16256, 16256, 16256, 16256, 16256, 16256, 16256};
    f32x16 pa0, pa1, pb0, pb1;
#pragma unroll
    for (int r = 0; r < 16; ++r) { pa1[r] = 0.f; pb1[r] = 0.f; }
    static_assert(MODE != 0, "attn_unit_seq issues one K and one V piece per wave and tile");
    issueK(0, 0); issueV(0, 0); if (NT > 1) { issueK(1, 1); issueV(1, 1); } if (NT > 2) issueK(2, 2);
    asm volatile("s_waitcnt vmcnt(0)" ::: "memory");
    __syncthreads();
    if (tile_act(0)) qk(0, pa0, pa1, 0.f);
    auto step = [&](int t, f32x16& c0, f32x16& c1, f32x16& x0, f32x16& x1) {
        if (t + 3 < NT) issueK(t + 3, (t + 3) & 3);
        if (t + 2 < NT) issueV(t + 2, (t + 2) & 3);
        const bool act = tile_act(t), actn = (t + 1 < NT) && tile_act(t + 1);
        if (actn) qk(t + 1, x0, x1, -mref);
        if (act) {
            const bool nb = (MODE == 1) && (t < n0);
            float rm;
            if (nb) { const int j = j0 + t, dr = j - rq + 7; const bool rowact = (j >= rs_q) && (j < rs_q + 8);
                const LAS float* tb_ = tab + 64 + dr * 32 + (ks0 + 4 * hi - qc + 15); const int kbase = rowact ? (ks0 + 4 * hi - cs) : 1000;
#pragma unroll
                for (int r = 0; r < 16; ++r) { const int ko = (r & 3) + 8 * (r >> 2); c0[r] = ((unsigned)(kbase + ko) < 16u) ? c0[r] + tb_[ko] : -1e30f; }
                float ra = __builtin_fmaxf(__builtin_fmaxf(c0[0], c0[1]), c0[2]), rb = __builtin_fmaxf(__builtin_fmaxf(c0[3], c0[4]), c0[5]);
                ra = __builtin_fmaxf(__builtin_fmaxf(ra, c0[6]), c0[7]); rb = __builtin_fmaxf(__builtin_fmaxf(rb, c0[8]), c0[9]);
                ra = __builtin_fmaxf(__builtin_fmaxf(ra, c0[10]), c0[11]); rb = __builtin_fmaxf(__builtin_fmaxf(rb, c0[12]), c0[13]);
                rm = __builtin_fmaxf(__builtin_fmaxf(ra, rb), __builtin_fmaxf(c0[14], c0[15]));
            } else {
                float ra = __builtin_fmaxf(__builtin_fmaxf(c0[0], c0[1]), c1[0]), rb = __builtin_fmaxf(__builtin_fmaxf(c0[2], c0[3]), c1[1]);
                ra = __builtin_fmaxf(__builtin_fmaxf(ra, c1[2]), c1[3]);
#pragma unroll
                for (int r = 4; r < 16; r += 4) { ra = __builtin_fmaxf(__builtin_fmaxf(ra, c0[r]), c0[r + 1]); rb = __builtin_fmaxf(__builtin_fmaxf(rb, c0[r + 2]), c0[r + 3]);
                    ra = __builtin_fmaxf(__builtin_fmaxf(ra, c1[r]), c1[r + 1]); rb = __builtin_fmaxf(__builtin_fmaxf(rb, c1[r + 2]), c1[r + 3]); }
                rm = __builtin_fmaxf(ra, rb);
            }
            { const u32x2_t sw_ = __builtin_amdgcn_permlane32_swap(__float_as_uint(rm), __float_as_uint(rm), false, false); rm = __builtin_fmaxf(__uint_as_float(sw_.x), __uint_as_float(sw_.y)); }
            const bool mv = (rm > 8.f) || (rm < -40.f && rm > -1e29f);
            if (__any(mv)) {
                const float dl = mv ? rm : 0.f; mref += dl; const float f = __builtin_amdgcn_exp2f(-dl);
#pragma unroll
                for (int r = 0; r < 16; ++r) { c0[r] -= dl; c1[r] -= dl; }
                if (actn) {
#pragma unroll
                    for (int r = 0; r < 16; ++r) { x0[r] -= dl; x1[r] -= dl; } }
                if (hi == 0) wsf[r32] = f;
                __builtin_amdgcn_s_waitcnt(0xc07f);
#pragma unroll
                for (int r = 0; r < 16; ++r) { const float fr_ = wsf[crow(r, hi)]; osum[r] *= fr_;
#pragma unroll
                    for (int d0 = 0; d0 < ND; ++d0) o[d0][r] *= fr_; }
            }
            const unsigned va = (unsigned)(size_t)(lds + 4 * KB + (t & 3) * VB + ((lane >> 4) & 1) * 32 + (lane & 3) * 8 + (4 * hi + ((lane & 15) >> 2)) * 64);
            if (nb) {
#pragma unroll
                for (int r = 0; r < 16; ++r) c0[r] = __builtin_amdgcn_exp2f(c0[r]);
                u32x4 pw[2];
#pragma unroll
                for (int k = 0; k < 2; ++k) pw[k] = (u32x4){cvt_pk_bf16(c0[8 * k], c0[8 * k + 1]), cvt_pk_bf16(c0[8 * k + 2], c0[8 * k + 3]), cvt_pk_bf16(c0[8 * k + 4], c0[8 * k + 5]), cvt_pk_bf16(c0[8 * k + 6], c0[8 * k + 7])};
                { const unsigned vb = va + (unsigned)(ks0 >> 3) * 512u;
                  s16x4 l00, h00, l01, h01, l10, h10, l11, h11;
                  SQ_VTR(l00, vb, 0); SQ_VTR(h00, vb, 512); SQ_VTR(l01, vb, 1024); SQ_VTR(h01, vb, 1536);
                  SQ_VTR(l10, vb, 4096); SQ_VTR(h10, vb, 4608); SQ_VTR(l11, vb, 5120); SQ_VTR(h11, vb, 5632);
                  bf16x8 f00 = (bf16x8){l00[0], l00[1], l00[2], l00[3], h00[0], h00[1], h00[2], h00[3]}, f01 = (bf16x8){l01[0], l01[1], l01[2], l01[3], h01[0], h01[1], h01[2], h01[3]};
                  bf16x8 f10 = (bf16x8){l10[0], l10[1], l10[2], l10[3], h10[0], h10[1], h10[2], h10[3]}, f11 = (bf16x8){l11[0], l11[1], l11[2], l11[3], h11[0], h11[1], h11[2], h11[3]};
                  SQ_SB;
#pragma unroll
                  for (int ks = 0; ks < 2; ++ks) osum = __builtin_amdgcn_mfma_f32_32x32x16_bf16(__builtin_bit_cast(bf16x8, pw[ks]), ones, osum, 0, 0, 0);
                  SQ_VW(0, f00, f01, f10, f11);
                  SQ_SB;
                  o[0] = __builtin_amdgcn_mfma_f32_32x32x16_bf16(__builtin_bit_cast(bf16x8, pw[0]), f00, o[0], 0, 0, 0);
                  o[1] = __builtin_amdgcn_mfma_f32_32x32x16_bf16(__builtin_bit_cast(bf16x8, pw[0]), f10, o[1], 0, 0, 0);
                  o[0] = __builtin_amdgcn_mfma_f32_32x32x16_bf16(__builtin_bit_cast(bf16x8, pw[1]), f01, o[0], 0, 0, 0);
                  o[1] = __builtin_amdgcn_mfma_f32_32x32x16_bf16(__builtin_bit_cast(bf16x8, pw[1]), f11, o[1], 0, 0, 0);
                  SQ_SB; }
            } else {
#pragma unroll
                for (int r = 0; r < 16; ++r) { c0[r] = __builtin_amdgcn_exp2f(c0[r]); c1[r] = __builtin_amdgcn_exp2f(c1[r]); }
                u32x4 pw[4];
#pragma unroll
                for (int k = 0; k < 2; ++k) {
                    pw[k] = (u32x4){cvt_pk_bf16(c0[8 * k], c0[8 * k + 1]), cvt_pk_bf16(c0[8 * k + 2], c0[8 * k + 3]), cvt_pk_bf16(c0[8 * k + 4], c0[8 * k + 5]), cvt_pk_bf16(c0[8 * k + 6], c0[8 * k + 7])};
                    pw[2 + k] = (u32x4){cvt_pk_bf16(c1[8 * k], c1[8 * k + 1]), cvt_pk_bf16(c1[8 * k + 2], c1[8 * k + 3]), cvt_pk_bf16(c1[8 * k + 4], c1[8 * k + 5]), cvt_pk_bf16(c1[8 * k + 6], c1[8 * k + 7])}; }
                { bf16x8 vf[2][4];
#define SQ_LDV(set, d0) do { s16x4 l0_, h0_, l1_, h1_, l2_, h2_, l3_, h3_; \
    SQ_VTR(l0_, va, (d0) * 4096); SQ_VTR(h0_, va, (d0) * 4096 + 512); SQ_VTR(l1_, va, (d0) * 4096 + 1024); SQ_VTR(h1_, va, (d0) * 4096 + 1536); \
    SQ_VTR(l2_, va, (d0) * 4096 + 2048); SQ_VTR(h2_, va, (d0) * 4096 + 2560); SQ_VTR(l3_, va, (d0) * 4096 + 3072); SQ_VTR(h3_, va, (d0) * 4096 + 3584); \
    vf[set][0] = (bf16x8){l0_[0], l0_[1], l0_[2], l0_[3], h0_[0], h0_[1], h0_[2], h0_[3]}; vf[set][1] = (bf16x8){l1_[0], l1_[1], l1_[2], l1_[3], h1_[0], h1_[1], h1_[2], h1_[3]}; \
    vf[set][2] = (bf16x8){l2_[0], l2_[1], l2_[2], l2_[3], h2_[0], h2_[1], h2_[2], h2_[3]}; vf[set][3] = (bf16x8){l3_[0], l3_[1], l3_[2], l3_[3], h3_[0], h3_[1], h3_[2], h3_[3]}; } while (0)
                  static_assert(ND == 2, "two 32-column blocks of V");
                  SQ_LDV(0, 0);
                  SQ_SB;
#pragma unroll
                  for (int ks = 0; ks < 4; ++ks) osum = __builtin_amdgcn_mfma_f32_32x32x16_bf16(__builtin_bit_cast(bf16x8, pw[ks]), ones, osum, 0, 0, 0);
                  SQ_LDV(1, 1);
                  SQ_VW(8, vf[0][0], vf[0][1], vf[0][2], vf[0][3]);
                  SQ_SB;
#pragma unroll
                  for (int ks = 0; ks < 4; ++ks) o[0] = __builtin_amdgcn_mfma_f32_32x32x16_bf16(__builtin_bit_cast(bf16x8, pw[ks]), vf[0][ks], o[0], 0, 0, 0);
                  SQ_SB;
                  SQ_VW(0, vf[1][0], vf[1][1], vf[1][2], vf[1][3]);
                  SQ_SB;
#pragma unroll
                  for (int ks = 0; ks < 4; ++ks) o[1] = __builtin_amdgcn_mfma_f32_32x32x16_bf16(__builtin_bit_cast(bf16x8, pw[ks]), vf[1][ks], o[1], 0, 0, 0);
                  SQ_SB; }
            }
        }
        if (t + 3 < NT) asm volatile("s_waitcnt vmcnt(2)" ::: "memory"); else asm volatile("s_waitcnt vmcnt(0)" ::: "memory");
        asm volatile("s_waitcnt lgkmcnt(0)" ::: "memory"); __builtin_amdgcn_s_barrier(); __builtin_amdgcn_sched_barrier(0);
    };
    for (int t = 0; t < NT; t += 2) {
        step(t, pa0, pa1, pb0, pb1);
        if (t + 1 < NT) step(t + 1, pb0, pb1, pa0, pa1);
    }
    float rl[16];
    { const float lamf = (MODE == 0 && msub == 1) ? p.LAM()[l] : 1.f;
#pragma unroll
      for (int r = 0; r < 16; ++r) rl[r] = lamf * __builtin_amdgcn_rcpf(osum[r]); }
    if (MODE == 0) {
        LAS float* x1 = (LAS float*)(lds + AT_X1) + (wid & 3) * 4096 + lane;
        if (msub == 1) {
#pragma unroll
            for (int d0 = 0; d0 < ND; ++d0)
#pragma unroll
                for (int r = 0; r < 16; ++r) x1[(d0 * 16 + r) * 64] = o[d0][r] * rl[r];
        }
        __syncthreads();
        if (msub == 0) {
            LAS float* st = (LAS float*)(lds + wid * 16896);
#pragma unroll
            for (int d0 = 0; d0 < ND; ++d0)
#pragma unroll
                for (int r = 0; r < 16; ++r) st[crow(r, hi) * 132 + d0 * 32 + r32] = o[d0][r] * rl[r] - x1[(d0 * 16 + r) * 64];
            __builtin_amdgcn_s_waitcnt(0xc07f);
            const int q = lane >> 1, half = lane & 1;
            f32x4 v[16]; float ss = 0.f;
#pragma unroll
            for (int i = 0; i < 16; ++i) { v[i] = *(const LAS f32x4*)(st + q * 132 + half * 64 + i * 4); ss += v[i][0] * v[i][0] + v[i][1] * v[i][1] + v[i][2] * v[i][2] + v[i][3] * v[i][3]; }
            ss += __shfl_xor(ss, 1);
            const float rn = rsqrtf(ss * (1.f / 128.f) + EPS) * (1.f - (0.8f - 0.6f * __expf(-0.3f * (float)l)));
            const float* g = p.da_subln_g + l * 128 + half * 64;
            bf16_t* dst = p.O() + (size_t)(qbase + q) * 1536 + h * 128 + half * 64;
#pragma unroll
            for (int i = 0; i < 8; ++i) { const f32x4 ga = *(const f32x4*)(g + i * 8), gb = *(const f32x4*)(g + i * 8 + 4); const f32x4 a = v[2 * i] * ga * rn, b = v[2 * i + 1] * gb * rn;
                u32x4 w; w.x = cvt_pk_bf16(a[0], a[1]); w.y = cvt_pk_bf16(a[2], a[3]); w.z = cvt_pk_bf16(b[0], b[1]); w.w = cvt_pk_bf16(b[2], b[3]);
                *(u32x4*)(dst + i * 8) = w; }
        }
    } else {
        LAS bf16_t* stg = (LAS bf16_t*)(lds + AT_X1 + wid * 4096);
#pragma unroll
        for (int r = 0; r < 16; ++r)
#pragma unroll
            for (int d0 = 0; d0 < ND; ++d0) stg[crow(r, hi) * 64 + d0 * 32 + r32] = f2bf(o[d0][r] * rl[r]);
        __builtin_amdgcn_s_waitcnt(0xc07f);
#pragma unroll
        for (int i = 0; i < 4; ++i) { const int row = i * 8 + (lane >> 3), ch = lane & 7; const u32x4 v = *(const LAS u32x4*)(stg + row * 64 + ch * 8);
            const int tok = (MODE == 1) ? qrow0 + (2 * rp + (row >> 4)) * 64 + 16 * g + (row & 15) : qbase + row;
            *(u32x4*)(p.O() + (size_t)tok * 1536 + 512 + h * 64 + ch * 8) = v; }
    }
    __syncthreads();
}

template <int MODE>
__device__ __forceinline__ void attn_unit(const P& p, int l, LAS unsigned char* lds, int h, int qrow0, int kb0, int n0, int kb1, int n1, int R0, int j0) {
    constexpr int DV = MODE == 0 ? 128 : 64, ND = DV / 32, KB = MODE == 0 ? 16384 : 8192, VB = DV * 64 * 2, SLOT = KB + VB;
    const int tid = otid(), lane = tid & 63, r32 = lane & 31, hi = lane >> 5, wid = __builtin_amdgcn_readfirstlane(tid >> 6);
    const int msub = MODE == 0 ? (wid >> 2) : 0;
    const int qbase = qrow0 + (MODE == 0 ? 32 * (wid & 3) : 32 * wid);
    const int qcol = MODE == 0 ? h * 128 + msub * 64 : 1536 + h * 64;
    const int kcol = MODE == 0 ? 512 + h * 128 : 2048 + h * 64;
    const int vcol = MODE == 0 ? 1024 + h * 128 : 2560 + h * 64;
    const int rp = wid >> 2, g = wid & 3, ks0 = min(max(16 * g - 8, 0), 32);
    int qtok = qbase + r32, rq = 0, rs_q = 0, qc = 0, cs = 0, rsA = 0, rsB = 0;
    if (MODE == 1) { rq = R0 + 2 * rp + (r32 >> 4); qc = 16 * g + (r32 & 15); qtok = qrow0 + (2 * rp + (r32 >> 4)) * 64 + qc;
        rs_q = min(max(rq - 4, 0), 24); cs = min(max(qc - 8, 0), 48); rsA = min(max(R0 + 2 * rp - 4, 0), 24); rsB = min(max(R0 + 2 * rp - 3, 0), 24); }
    bf16x8 qr[4];
#pragma unroll
    for (int d0 = 0; d0 < 4; ++d0) qr[d0] = *(const bf16x8*)(p.QKV() + (size_t)qtok * 3072 + qcol + d0 * 16 + hi * 8);
    LAS float* wsf = (LAS float*)(lds + AT_WSF + wid * 256);
    LAS float* tab = (LAS float*)(lds + AT_TAB);
    if (MODE == 1) { for (int i = tid; i < 768; i += 512) { const int idx = i - 64; float v = 0.f;
            if (idx >= 0 && idx < 480) { const int dr = idx >> 5, dc = idx & 31; if (dc < 31) v = p.na_rpb[((size_t)(l * 8 + h) * 15 + dr) * 31 + dc] * 1.4426950408889634f; }
            tab[i] = v; } }
    const int NT = n0 + n1;
    auto issueK = [&](int t, int s) {
      for (int rr_ = 0; rr_ < REP_DMA; ++rr_) {
        const int tb = t < n0 ? kb0 + 64 * t : kb1 + 64 * (t - n0); LAS unsigned char* slot = lds + s * KB;
        if (MODE == 0) {
#pragma unroll
            for (int i = 0; i < 2; ++i) { const int id = wid * 2 + i;
                __builtin_amdgcn_global_load_lds((const unsigned*)(p.QKV() + (size_t)(tb + 8 * (id & 7) + (lane & 7)) * 3072 + kcol + (id >> 3) * 64 + ((lane >> 3) ^ (id & 1)) * 8), (LAS unsigned*)(slot + (id >> 3) * 8192 + (id & 7) * 1024), 16, 0, 0); }
        } else __builtin_amdgcn_global_load_lds((const unsigned*)(p.QKV() + (size_t)(tb + 8 * wid + (lane & 7)) * 3072 + kcol + ((lane >> 3) ^ (wid & 1)) * 8), (LAS unsigned*)(slot + wid * 1024), 16, 0, 0);
      }
    };
    auto issueV = [&](int t, int s) {
      for (int rr_ = 0; rr_ < REP_DMA; ++rr_) {
        const int tb = t < n0 ? kb0 + 64 * t : kb1 + 64 * (t - n0); LAS unsigned char* slot = lds + 3 * KB + s * VB;
        if (MODE == 0) {
#pragma unroll
            for (int i = 0; i < 2; ++i) { const int id = wid * 2 + i;
                __builtin_amdgcn_global_load_lds((const unsigned*)(p.QKV() + (size_t)(tb + 16 * (id & 3) + (lane >> 2)) * 3072 + vcol + 32 * (id >> 2) + (lane & 3) * 8), (LAS unsigned*)(slot + (id >> 2) * 4096 + (id & 3) * 1024), 16, 0, 0); }
        } else __builtin_amdgcn_global_load_lds((const unsigned*)(p.QKV() + (size_t)(tb + 16 * (wid & 3) + (lane >> 2)) * 3072 + vcol + 32 * (wid >> 2) + (lane & 3) * 8), (LAS unsigned*)(slot + (wid >> 2) * 4096 + (wid & 3) * 1024), 16, 0, 0);
      }
    };
    auto tile_act = [&](int t) -> bool { if (MODE != 1 || t >= n0) return true; const int j = j0 + t; return (j >= rsA) && (j < rsB + 8); };
    auto qk_load = [&](int t, int sl, bf16x8 (&kf)[8]) {
        const bool nbt = (MODE == 1) && (t < n0);
        const int kb_ = ((nbt ? ks0 : 0) + r32) >> 3; const LAS unsigned char* kp = lds + sl * KB + (nbt ? 0 : msub * 8192) + kb_ * 1024 + (r32 & 7) * 16 + ((hi ^ (kb_ & 1)) * 128);
#pragma unroll
        for (int d0 = 0; d0 < 4; ++d0) kf[2 * d0] = *(const LAS bf16x8*)(kp + d0 * 256);
        if (!nbt) {
#pragma unroll
            for (int d0 = 0; d0 < 4; ++d0) kf[2 * d0 + 1] = *(const LAS bf16x8*)(kp + d0 * 256 + 4096); }
    };
    auto qk_mma = [&](int t, const bf16x8 (&kf)[8], f32x16& a0, f32x16& a1, float init) {
        if (MODE == 1 && t < n0) {
#pragma unroll
            for (int r = 0; r < 16; ++r) a0[r] = init;
#pragma unroll
            for (int d0 = 0; d0 < 4; ++d0) a0 = __builtin_amdgcn_mfma_f32_32x32x16_bf16(kf[2 * d0], qr[d0], a0, 0, 0, 0);
        } else {
#pragma unroll
            for (int r = 0; r < 16; ++r) { a0[r] = init; a1[r] = init; }
#pragma unroll
            for (int d0 = 0; d0 < 4; ++d0) { a0 = __builtin_amdgcn_mfma_f32_32x32x16_bf16(kf[2 * d0], qr[d0], a0, 0, 0, 0); a1 = __builtin_amdgcn_mfma_f32_32x32x16_bf16(kf[2 * d0 + 1], qr[d0], a1, 0, 0, 0); }
        }
    };
    f32x16 o[ND];
#pragma unroll
    for (int d0 = 0; d0 < ND; ++d0)
#pragma unroll
        for (int r = 0; r < 16; ++r) o[d0][r] = 0.f;
    float mref = 0.f;
    f32x16 osum;
#pragma unroll
    for (int r = 0; r < 16; ++r) osum[r] = 0.f;
    const bf16x8 ones = (bf16x8){16256, 16256, 16256, 16256, 16256, 16256, 16256, 16256};
    f32x16 c0, c1;
    u32x4 pw[4];
#pragma unroll
    for (int r = 0; r < 16; ++r) c1[r] = 0.f;
#define AT_BAR do { asm volatile("s_waitcnt lgkmcnt(0)" ::: "memory"); __builtin_amdgcn_s_barrier(); __builtin_amdgcn_sched_barrier(0); } while (0)
#define AT_WV0 asm volatile("s_waitcnt vmcnt(0)" ::: "memory")
    issueK(0, 0); issueV(0, 0); if (NT > 1) { issueK(1, 1); issueV(1, 1); } if (NT > 2) issueK(2, 2);
    AT_WV0;
    AT_BAR;
    const int grp = wid >> 2;
    int s0 = 0, s1 = 1, s2 = 2;
    auto issueKV = [&](int t) { if (t + 3 < NT) issueK(t + 3, s0); if (t + 2 < NT) issueV(t + 2, s2); };
    auto waitKV = [&](int t) { if (t + 3 < NT) { if (MODE == 0) asm volatile("s_waitcnt vmcnt(4)" ::: "memory"); else asm volatile("s_waitcnt vmcnt(2)" ::: "memory"); } else AT_WV0; };
    auto Vph = [&](int t) {
        if (!tile_act(t)) return;
        const bool nb = (MODE == 1) && (t < n0);
        float rm;
        if (nb) { const int j = j0 + t, dr = j - rq + 7; const bool rowact = (j >= rs_q) && (j < rs_q + 8);
            const LAS float* tb_ = tab + 64 + dr * 32 + (ks0 + 4 * hi - qc + 15); const int kbase = rowact ? (ks0 + 4 * hi - cs) : 1000;
#pragma unroll
            for (int r = 0; r < 16; ++r) { const int ko = (r & 3) + 8 * (r >> 2); c0[r] = ((unsigned)(kbase + ko) < 16u) ? c0[r] + tb_[ko] : -1e30f; }
            float ra = __builtin_fmaxf(__builtin_fmaxf(c0[0], c0[1]), c0[2]), rb = __builtin_fmaxf(__builtin_fmaxf(c0[3], c0[4]), c0[5]);
            ra = __builtin_fmaxf(__builtin_fmaxf(ra, c0[6]), c0[7]); rb = __builtin_fmaxf(__builtin_fmaxf(rb, c0[8]), c0[9]);
            ra = __builtin_fmaxf(__builtin_fmaxf(ra, c0[10]), c0[11]); rb = __builtin_fmaxf(__builtin_fmaxf(rb, c0[12]), c0[13]);
            rm = __builtin_fmaxf(__builtin_fmaxf(ra, rb), __builtin_fmaxf(c0[14], c0[15]));
        } else {
            float ra = __builtin_fmaxf(__builtin_fmaxf(c0[0], c0[1]), c1[0]), rb = __builtin_fmaxf(__builtin_fmaxf(c0[2], c0[3]), c1[1]);
            ra = __builtin_fmaxf(__builtin_fmaxf(ra, c1[2]), c1[3]);
#pragma unroll
            for (int r = 4; r < 16; r += 4) { ra = __builtin_fmaxf(__builtin_fmaxf(ra, c0[r]), c0[r + 1]); rb = __builtin_fmaxf(__builtin_fmaxf(rb, c0[r + 2]), c0[r + 3]);
                ra = __builtin_fmaxf(__builtin_fmaxf(ra, c1[r]), c1[r + 1]); rb = __builtin_fmaxf(__builtin_fmaxf(rb, c1[r + 2]), c1[r + 3]); }
            rm = __builtin_fmaxf(ra, rb);
        }
        { const u32x2_t sw_ = __builtin_amdgcn_permlane32_swap(__float_as_uint(rm), __float_as_uint(rm), false, false); rm = __builtin_fmaxf(__uint_as_float(sw_.x), __uint_as_float(sw_.y)); }
        const bool mv = (rm > 8.f) || (rm < -40.f && rm > -1e29f);
        if (__any(mv)) {
            const float dl = mv ? rm : 0.f; mref += dl; const float f = __builtin_amdgcn_exp2f(-dl);
#pragma unroll
            for (int r = 0; r < 16; ++r) { c0[r] -= dl; c1[r] -= dl; }
            if (hi == 0) wsf[r32] = f;
            __builtin_amdgcn_s_waitcnt(0xc07f);
#pragma unroll
            for (int r = 0; r < 16; ++r) { const float fr_ = wsf[crow(r, hi)]; osum[r] *= fr_;
#pragma unroll
                for (int d0 = 0; d0 < ND; ++d0) o[d0][r] *= fr_; }
        }
        if (nb) {
#pragma unroll
            for (int r = 0; r < 16; ++r) c0[r] = __builtin_amdgcn_exp2f(c0[r]);
#pragma unroll
            for (int k = 0; k < 2; ++k) pw[k] = (u32x4){cvt_pk_bf16(c0[8 * k], c0[8 * k + 1]), cvt_pk_bf16(c0[8 * k + 2], c0[8 * k + 3]), cvt_pk_bf16(c0[8 * k + 4], c0[8 * k + 5]), cvt_pk_bf16(c0[8 * k + 6], c0[8 * k + 7])};
            asm volatile("" : "+v"(pw[0]), "+v"(pw[1]));
        } else {
#pragma unroll
            for (int r = 0; r < 16; ++r) {
#if REP_XP > 1
                { float d0_ = __builtin_amdgcn_exp2f(c0[r] - 1.f), d1_ = __builtin_amdgcn_exp2f(c1[r] - 1.f); asm volatile("" :: "v"(d0_), "v"(d1_)); }
#endif
                c0[r] = __builtin_amdgcn_exp2f(c0[r]); c1[r] = __builtin_amdgcn_exp2f(c1[r]); }
#pragma unroll
            for (int k = 0; k < 2; ++k) {
                pw[k] = (u32x4){cvt_pk_bf16(c0[8 * k], c0[8 * k + 1]), cvt_pk_bf16(c0[8 * k + 2], c0[8 * k + 3]), cvt_pk_bf16(c0[8 * k + 4], c0[8 * k + 5]), cvt_pk_bf16(c0[8 * k + 6], c0[8 * k + 7])};
                pw[2 + k] = (u32x4){cvt_pk_bf16(c1[8 * k], c1[8 * k + 1]), cvt_pk_bf16(c1[8 * k + 2], c1[8 * k + 3]), cvt_pk_bf16(c1[8 * k + 4], c1[8 * k + 5]), cvt_pk_bf16(c1[8 * k + 6], c1[8 * k + 7])}; }
            asm volatile("" : "+v"(pw[0]), "+v"(pw[1]), "+v"(pw[2]), "+v"(pw[3]));
        }
    };
#define AT_SB __builtin_amdgcn_sched_barrier(0)
#define AT_VTR(dst, addr, off) asm volatile("ds_read_b64_tr_b16 %0, %1 offset:%2" : "=v"(dst) : "v"(addr), "n"(off) : "memory")
#define AT_VW(n, f0, f1, f2, f3) asm volatile("s_waitcnt lgkmcnt(" #n ")" : "+v"(f0), "+v"(f1), "+v"(f2), "+v"(f3) :: "memory")
    auto Mph = [&](int t) {
        const bool act = tile_act(t), actn = (t + 1 < NT) && tile_act(t + 1);
        bf16x8 kf[8];
        if (actn) qk_load(t + 1, s1, kf);
        if (act) {
            const bool nb = (MODE == 1) && (t < n0);
            const unsigned va = (unsigned)(size_t)(lds + 3 * KB + s0 * VB + ((lane >> 4) & 1) * 32 + (lane & 3) * 8 + (4 * hi + ((lane & 15) >> 2)) * 64);
            if (nb) {
                const unsigned vb = va + (unsigned)(ks0 >> 3) * 512u;
                s16x4 l00, h00, l01, h01, l10, h10, l11, h11;
                AT_VTR(l00, vb, 0); AT_VTR(h00, vb, 512); AT_VTR(l01, vb, 1024); AT_VTR(h01, vb, 1536);
                AT_VTR(l10, vb, 4096); AT_VTR(h10, vb, 4608); AT_VTR(l11, vb, 5120); AT_VTR(h11, vb, 5632);
                bf16x8 f00 = (bf16x8){l00[0], l00[1], l00[2], l00[3], h00[0], h00[1], h00[2], h00[3]}, f01 = (bf16x8){l01[0], l01[1], l01[2], l01[3], h01[0], h01[1], h01[2], h01[3]};
                bf16x8 f10 = (bf16x8){l10[0], l10[1], l10[2], l10[3], h10[0], h10[1], h10[2], h10[3]}, f11 = (bf16x8){l11[0], l11[1], l11[2], l11[3], h11[0], h11[1], h11[2], h11[3]};
                AT_SB;
#pragma unroll
                for (int ks = 0; ks < 2; ++ks) osum = __builtin_amdgcn_mfma_f32_32x32x16_bf16(__builtin_bit_cast(bf16x8, pw[ks]), ones, osum, 0, 0, 0);
                AT_VW(0, f00, f01, f10, f11);
                AT_SB;
                o[0] = __builtin_amdgcn_mfma_f32_32x32x16_bf16(__builtin_bit_cast(bf16x8, pw[0]), f00, o[0], 0, 0, 0);
                o[1] = __builtin_amdgcn_mfma_f32_32x32x16_bf16(__builtin_bit_cast(bf16x8, pw[0]), f10, o[1], 0, 0, 0);
                o[0] = __builtin_amdgcn_mfma_f32_32x32x16_bf16(__builtin_bit_cast(bf16x8, pw[1]), f01, o[0], 0, 0, 0);
                o[1] = __builtin_amdgcn_mfma_f32_32x32x16_bf16(__builtin_bit_cast(bf16x8, pw[1]), f11, o[1], 0, 0, 0);
                AT_SB;
            } else {
                bf16x8 vf[2][4];
#define AT_LDV(set, d0) do { s16x4 l0_, h0_, l1_, h1_, l2_, h2_, l3_, h3_; \
    AT_VTR(l0_, va, (d0) * 4096); AT_VTR(h0_, va, (d0) * 4096 + 512); AT_VTR(l1_, va, (d0) * 4096 + 1024); AT_VTR(h1_, va, (d0) * 4096 + 1536); \
    AT_VTR(l2_, va, (d0) * 4096 + 2048); AT_VTR(h2_, va, (d0) * 4096 + 2560); AT_VTR(l3_, va, (d0) * 4096 + 3072); AT_VTR(h3_, va, (d0) * 4096 + 3584); \
    vf[set][0] = (bf16x8){l0_[0], l0_[1], l0_[2], l0_[3], h0_[0], h0_[1], h0_[2], h0_[3]}; vf[set][1] = (bf16x8){l1_[0], l1_[1], l1_[2], l1_[3], h1_[0], h1_[1], h1_[2], h1_[3]}; \
    vf[set][2] = (bf16x8){l2_[0], l2_[1], l2_[2], l2_[3], h2_[0], h2_[1], h2_[2], h2_[3]}; vf[set][3] = (bf16x8){l3_[0], l3_[1], l3_[2], l3_[3], h3_[0], h3_[1], h3_[2], h3_[3]}; } while (0)
                AT_LDV(0, 0);
                AT_SB;
#pragma unroll
                for (int ks = 0; ks < 4; ++ks) osum = __builtin_amdgcn_mfma_f32_32x32x16_bf16(__builtin_bit_cast(bf16x8, pw[ks]), ones, osum, 0, 0, 0);
                AT_LDV(1, 1);
                AT_VW(8, vf[0][0], vf[0][1], vf[0][2], vf[0][3]);
                AT_SB;
#pragma unroll
                for (int ks = 0; ks < 4; ++ks) o[0] = __builtin_amdgcn_mfma_f32_32x32x16_bf16(__builtin_bit_cast(bf16x8, pw[ks]), vf[0][ks], o[0], 0, 0, 0);
#if REP_PV > 1
                { const bf16x8 zz = (bf16x8){0,0,0,0,0,0,0,0};
#pragma unroll
                  for (int d0 = 0; d0 < ND; ++d0)
#pragma unroll
                    for (int ks = 0; ks < 4; ++ks) o[d0] = __builtin_amdgcn_mfma_f32_32x32x16_bf16(zz, vf[0][ks], o[d0], 0, 0, 0); }
#endif
                AT_SB;
                if (ND == 4) {
                    AT_LDV(0, 2);
                    AT_VW(8, vf[1][0], vf[1][1], vf[1][2], vf[1][3]);
                    AT_SB;
#pragma unroll
                    for (int ks = 0; ks < 4; ++ks) o[1] = __builtin_amdgcn_mfma_f32_32x32x16_bf16(__builtin_bit_cast(bf16x8, pw[ks]), vf[1][ks], o[1], 0, 0, 0);
                    AT_SB;
                    AT_LDV(1, 3);
                    AT_VW(8, vf[0][0], vf[0][1], vf[0][2], vf[0][3]);
                    AT_SB;
#pragma unroll
                    for (int ks = 0; ks < 4; ++ks) o[ND - 2] = __builtin_amdgcn_mfma_f32_32x32x16_bf16(__builtin_bit_cast(bf16x8, pw[ks]), vf[0][ks], o[ND - 2], 0, 0, 0);
                    AT_SB;
                }
                AT_VW(0, vf[1][0], vf[1][1], vf[1][2], vf[1][3]);
                AT_SB;
#pragma unroll
                for (int ks = 0; ks < 4; ++ks) o[ND - 1] = __builtin_amdgcn_mfma_f32_32x32x16_bf16(__builtin_bit_cast(bf16x8, pw[ks]), vf[1][ks], o[ND - 1], 0, 0, 0);
                AT_SB;
            }
        }
        if (actn) qk_mma(t + 1, kf, c0, c1, -mref);
    };
    if (grp) AT_BAR;
    if (tile_act(0)) { bf16x8 kf0[8]; qk_load(0, 0, kf0); qk_mma(0, kf0, c0, c1, 0.f); }
    AT_BAR;
    for (int t = 0; t < NT; ++t) {
        if (grp == 1) issueKV(t);
        Vph(t);
        if (grp == 0) waitKV(t - 1);
        AT_BAR;
        if (grp == 0) issueKV(t);
        Mph(t);
        if (grp == 1) waitKV(t);
        AT_BAR;
        { const int s_ = s0; s0 = s1; s1 = s2; s2 = s_; }
    }
    if (!grp) AT_BAR;
    float rl[16];
    { const float lamf = (MODE == 0 && msub == 1) ? p.LAM()[l] : 1.f;
#pragma unroll
      for (int r = 0; r < 16; ++r) rl[r] = lamf * __builtin_amdgcn_rcpf(osum[r]); }
    if (MODE == 0) {
        LAS float* x1 = (LAS float*)(lds + AT_X1) + (wid & 3) * 4096 + lane;
        if (msub == 1) {
#pragma unroll
            for (int d0 = 0; d0 < ND; ++d0)
#pragma unroll
                for (int r = 0; r < 16; ++r) x1[(d0 * 16 + r) * 64] = o[d0][r] * rl[r];
        }
        __syncthreads();
        if (msub == 0) {
            LAS float* st = (LAS float*)(lds + wid * 16896);
#pragma unroll
            for (int d0 = 0; d0 < ND; ++d0)
#pragma unroll
                for (int r = 0; r < 16; ++r) st[crow(r, hi) * 132 + d0 * 32 + r32] = o[d0][r] * rl[r] - x1[(d0 * 16 + r) * 64];
            __builtin_amdgcn_s_waitcnt(0xc07f);
            const int q = lane >> 1, half = lane & 1;
            f32x4 v[16]; float ss = 0.f;
#pragma unroll
            for (int i = 0; i < 16; ++i) { v[i] = *(const LAS f32x4*)(st + q * 132 + half * 64 + i * 4); ss += v[i][0] * v[i][0] + v[i][1] * v[i][1] + v[i][2] * v[i][2] + v[i][3] * v[i][3]; }
            ss += __shfl_xor(ss, 1);
            const float rn = rsqrtf(ss * (1.f / 128.f) + EPS) * (1.f - (0.8f - 0.6f * __expf(-0.3f * (float)l)));
            const float* g = p.da_subln_g + l * 128 + half * 64;
            bf16_t* dst = p.O() + (size_t)(qbase + q) * 1536 + h * 128 + half * 64;
#pragma unroll
            for (int i = 0; i < 8; ++i) { const f32x4 ga = *(const f32x4*)(g + i * 8), gb = *(const f32x4*)(g + i * 8 + 4); const f32x4 a = v[2 * i] * ga * rn, b = v[2 * i + 1] * gb * rn;
                u32x4 w; w.x = cvt_pk_bf16(a[0], a[1]); w.y = cvt_pk_bf16(a[2], a[3]); w.z = cvt_pk_bf16(b[0], b[1]); w.w = cvt_pk_bf16(b[2], b[3]);
                *(u32x4*)(dst + i * 8) = w; }
        }
    } else {
        LAS bf16_t* stg = (LAS bf16_t*)(lds + AT_X1 + wid * 4096);
#pragma unroll
        for (int r = 0; r < 16; ++r)
#pragma unroll
            for (int d0 = 0; d0 < ND; ++d0) stg[crow(r, hi) * 64 + d0 * 32 + r32] = f2bf(o[d0][r] * rl[r]);
        __builtin_amdgcn_s_waitcnt(0xc07f);
#pragma unroll
        for (int i = 0; i < 4; ++i) { const int row = i * 8 + (lane >> 3), ch = lane & 7; const u32x4 v = *(const LAS u32x4*)(stg + row * 64 + ch * 8);
            const int tok = (MODE == 1) ? qrow0 + (2 * rp + (row >> 4)) * 64 + 16 * g + (row & 15) : qbase + row;
            *(u32x4*)(p.O() + (size_t)tok * 1536 + 512 + h * 64 + ch * 8) = v; }
    }
    __syncthreads();
}

constexpr int LDS_BARW = LDS_TOTAL - 64;

#define XB_TMO      128
#define XB_XCNT(j)  (256  + 64 * (j))
#define XB_XSUB(j)  (1280 + 64 * (j))
#define XB_XGEN(j)  (2304 + 64 * (j))
#define XB_TOP      3328
#define XB_TOPGEN   3392
#define XCD_BAR_WORDS 3456
#define XB_SPIN_CAP (1u << 18)

__device__ __forceinline__ unsigned xb_ld(unsigned* p)              { return __hip_atomic_load(p, __ATOMIC_RELAXED, __HIP_MEMORY_SCOPE_AGENT); }
__device__ __forceinline__ unsigned xb_add(unsigned* p, unsigned v) { return __hip_atomic_fetch_add(p, v, __ATOMIC_RELAXED, __HIP_MEMORY_SCOPE_AGENT); }
__device__ __forceinline__ unsigned xb_xcc_id() { return (unsigned)__builtin_amdgcn_s_getreg((3 << 11) | 20) & 0xFu; }
#define XB_SPIN(cond, bar) do { unsigned _sp = 0; while (cond) { __builtin_amdgcn_s_sleep(1); \
    if ((++_sp & 255u) == 0u) { if (xb_ld(&(bar)[XB_TMO])) break; if (_sp > XB_SPIN_CAP) { atomicAdd(&(bar)[XB_TMO], 1u); break; } } } } while (0)

struct XcdBarrier {
    unsigned* bar; unsigned x;
    volatile LAS unsigned* st;
};

__device__ __forceinline__ XcdBarrier xcd_barrier_post(unsigned* bar, volatile LAS unsigned* st) {
    XcdBarrier b; b.bar = bar; b.x = xb_xcc_id(); b.st = st;
    if (threadIdx.x == 0) (void)xb_add(&bar[XB_XCNT(b.x)], 1u);
    return b;
}
__device__ __forceinline__ void xcd_barrier_complete(unsigned* bar, unsigned x, unsigned& nloc, unsigned& nx) {
    const unsigned G = gridDim.x * gridDim.y * gridDim.z;
    unsigned sum, cnt, mine, sp = 0u;
    for (;;) {
        sum = 0u; cnt = 0u; mine = 0u;
#pragma unroll
        for (unsigned j = 0; j < 16; ++j) { const unsigned c = xb_ld(&bar[XB_XCNT(j)]); sum += c; cnt += (c > 0u) ? 1u : 0u; mine = (j == x) ? c : mine; }
        if (sum == G) break;
        __builtin_amdgcn_s_sleep(1);
        if ((++sp & 255u) == 0u) { if (xb_ld(&bar[XB_TMO])) break; if (sp > XB_SPIN_CAP) { atomicAdd(&bar[XB_TMO], 1u); break; } }
    }
    nloc = mine > 0u ? mine : 1u; nx = cnt > 0u ? cnt : 1u;
}

__device__ __forceinline__ void xcd_barrier(const XcdBarrier& b) {
    asm volatile("s_waitcnt vmcnt(0)" ::: "memory");
    __syncthreads();
    if (threadIdx.x == 0) {
        unsigned* bar = b.bar;
        __builtin_amdgcn_s_waitcnt(0);
        unsigned nloc = b.st[0], nx = b.st[1];
        unsigned bx = b.x; asm volatile("" : "+s"(bx));
        if (nloc == 0u) { xcd_barrier_complete(bar, bx, nloc, nx); b.st[0] = nloc; b.st[1] = nx; }
        const unsigned old = xb_add(&bar[XB_XSUB(bx)], 1u);
        const unsigned gen = old / nloc;
        if (old + 1u == (gen + 1u) * nloc) {
            __builtin_amdgcn_fence(__ATOMIC_RELEASE, "agent");
            asm volatile("s_waitcnt vmcnt(0)" ::: "memory");
            const unsigned og = xb_add(&bar[XB_TOP], 1u);
            const unsigned tg = og / nx;
            if (og + 1u == (tg + 1u) * nx) xb_add(&bar[XB_TOPGEN], 1u);
            else XB_SPIN(xb_ld(&bar[XB_TOPGEN]) == tg, bar);
            __builtin_amdgcn_fence(__ATOMIC_ACQUIRE, "agent");
            xb_add(&bar[XB_XGEN(bx)], 1u);
            asm volatile("s_waitcnt vmcnt(0)" ::: "memory");
        } else {
            XB_SPIN(xb_ld(&bar[XB_XGEN(bx)]) == gen, bar);
            __builtin_amdgcn_fence(__ATOMIC_ACQUIRE, "agent");
            asm volatile("s_waitcnt vmcnt(0)" ::: "memory");
        }
    }
    __syncthreads();
}

__device__ __forceinline__ void row_combine(const P& p, int lprev, int row, int lane, float4 (&v)[4], float scale = 1.f) {
    const float* md = p.MOD() + (size_t)(lprev * 9 + modidx(row)) * NMOD + 5 * D;
    int ri[4];
#pragma unroll
    for (int k = 0; k < 4; ++k) ri[k] = p.ROWIDX()[row * 4 + k];
#pragma unroll
    for (int i = 0; i < 4; ++i) { const int c = (lane + 64 * i) * 4; float4 s = {0.f, 0.f, 0.f, 0.f};
#pragma unroll
        for (int k = 0; k < 4; ++k) { const ushort4 y = *(const ushort4*)(p.YS() + (size_t)ri[k] * D + c); s.x += bf2f(y.x); s.y += bf2f(y.y); s.z += bf2f(y.z); s.w += bf2f(y.w); }
        float4 g2 = *(const float4*)(md + c); g2.x *= scale; g2.y *= scale; g2.z *= scale; g2.w *= scale;
        v[i].x += g2.x * s.x; v[i].y += g2.y * s.y; v[i].z += g2.z * s.z; v[i].w += g2.w * s.w; }
}
__device__ __forceinline__ void row_combine_c(const P& p, const int (&ri)[4], int lane, float4 (&v)[4], const float4 (&g2)[4]) {
#pragma unroll
    for (int i = 0; i < 4; ++i) { const int c = (lane + 64 * i) * 4; float4 s = {0.f, 0.f, 0.f, 0.f};
#pragma unroll
        for (int k = 0; k < 4; ++k) { const ushort4 y = *(const ushort4*)(p.YS() + (size_t)ri[k] * D + c); s.x += bf2f(y.x); s.y += bf2f(y.y); s.z += bf2f(y.z); s.w += bf2f(y.w); }
        v[i].x += g2[i].x * s.x; v[i].y += g2[i].y * s.y; v[i].z += g2[i].z * s.z; v[i].w += g2[i].w * s.w; }
}
__device__ __forceinline__ void ph_norm1(const P& p, int l, int G, int c, float scale = 1.f) {
    const int t_ = otid(), wid = t_ >> 6, lane = t_ & 63;
    const float* g = p.nmg + l * D;
    const int RPB = (T + G - 1) / G;
    int cm = -1; float4 cA[4], cB[4], cG2[4];
#pragma unroll
    for (int i = 0; i < 4; ++i) { cA[i] = make_float4(0.f, 0.f, 0.f, 0.f); cB[i] = cA[i]; cG2[i] = cA[i]; }
    int rin[4] = {0, 0, 0, 0};
    if (l > 0 && wid < RPB && c * RPB + wid < T) {
#pragma unroll
        for (int k = 0; k < 4; ++k) rin[k] = p.ROWIDX()[(c * RPB + wid) * 4 + k]; }
    for (int ri = wid; ri < RPB; ri += 8) {
        const int row = c * RPB + ri; if (row >= T) break;
        int rcur[4] = {rin[0], rin[1], rin[2], rin[3]};
        if (l > 0 && ri + 8 < RPB && row + 8 < T) {
#pragma unroll
            for (int k = 0; k < 4; ++k) rin[k] = p.ROWIDX()[(row + 8) * 4 + k]; }
        const int m = modidx(row);
        if (m != cm) { cm = m; const float* md = p.MOD() + (size_t)(l * 9 + m) * NMOD;
#pragma unroll
            for (int i = 0; i < 4; ++i) { const int cc = (lane + 64 * i) * 4; const float4 gg = *(const float4*)(g + cc), sh = *(const float4*)(md + cc), sc = *(const float4*)(md + D + cc);
                cA[i] = make_float4(gg.x * (1.f + sc.x), gg.y * (1.f + sc.y), gg.z * (1.f + sc.z), gg.w * (1.f + sc.w)); cB[i] = sh;
                if (l > 0) { const float4 q = *(const float4*)(p.MOD() + (size_t)((l - 1) * 9 + m) * NMOD + 5 * D + cc); cG2[i] = make_float4(q.x * scale, q.y * scale, q.z * scale, q.w * scale); } } }
        float4 v[4];
        if (l == 0) { const float4* xr = (const float4*)(row < TX ? p.x + (size_t)row * D : p.ctx + (size_t)(row - TX) * D);
#pragma unroll
            for (int i = 0; i < 4; ++i) v[i] = xr[lane + 64 * i];
        } else {
#pragma unroll
            for (int i = 0; i < 4; ++i) v[i] = ldx4(p.X() + (size_t)row * D + (lane + 64 * i) * 4); }
        if (l > 0) row_combine_c(p, rcur, lane, v, cG2);
        float ss = 0.f;
#pragma unroll
        for (int i = 0; i < 4; ++i) { uint2 w; w.x = cvt_pk_bf16(v[i].x, v[i].y); w.y = cvt_pk_bf16(v[i].z, v[i].w); *(uint2*)(p.X() + (size_t)row * D + (lane + 64 * i) * 4) = w; ss += v[i].x * v[i].x + v[i].y * v[i].y + v[i].z * v[i].z + v[i].w * v[i].w; }
        ss = wave_sum(ss); const float rs = rsqrtf(ss * (1.f / D) + EPS);
#pragma unroll
        for (int i = 0; i < 4; ++i) { const int cc = (lane + 64 * i) * 4;
            ushort4 o; o.x = f2bf(v[i].x * rs * cA[i].x + cB[i].x); o.y = f2bf(v[i].y * rs * cA[i].y + cB[i].y); o.z = f2bf(v[i].z * rs * cA[i].z + cB[i].z); o.w = f2bf(v[i].w * rs * cA[i].w + cB[i].w);
            *(ushort4*)(p.H1() + (size_t)row * D + cc) = o; }
    }
}
__device__ __forceinline__ void ph_final(const P& p, int G, int c) {
    const int t_ = otid(), wid = t_ >> 6, lane = t_ & 63;
    const int RPB = (TX + G - 1) / G;
    int cm = -1; float4 cG2[4], cF[4];
#pragma unroll
    for (int i = 0; i < 4; ++i) { cF[i] = *(const float4*)(p.final_g + (lane + 64 * i) * 4); cG2[i] = make_float4(0.f, 0.f, 0.f, 0.f); }
    int rin[4] = {0, 0, 0, 0};
    if (wid < RPB && c * RPB + wid < TX) {
#pragma unroll
        for (int k = 0; k < 4; ++k) rin[k] = p.ROWIDX()[(c * RPB + wid) * 4 + k]; }
    for (int ri = wid; ri < RPB; ri += 8) {
        const int row = c * RPB + ri; if (row >= TX) break;
        int rcur[4] = {rin[0], rin[1], rin[2], rin[3]};
        if (ri + 8 < RPB && row + 8 < TX) {
#pragma unroll
            for (int k = 0; k < 4; ++k) rin[k] = p.ROWIDX()[(row + 8) * 4 + k]; }
        const int m = modidx(row);
        if (m != cm) { cm = m;
#pragma unroll
            for (int i = 0; i < 4; ++i) cG2[i] = *(const float4*)(p.MOD() + (size_t)((DEPTH - 1) * 9 + m) * NMOD + 5 * D + (lane + 64 * i) * 4); }
        float4 v[4];
#pragma unroll
        for (int i = 0; i < 4; ++i) v[i] = ldx4(p.X() + (size_t)row * D + (lane + 64 * i) * 4);
        row_combine_c(p, rcur, lane, v, cG2);
        float ss = 0.f;
#pragma unroll
        for (int i = 0; i < 4; ++i) ss += v[i].x * v[i].x + v[i].y * v[i].y + v[i].z * v[i].z + v[i].w * v[i].w;
        ss = wave_sum(ss); const float rs = rsqrtf(ss * (1.f / D) + EPS);
#pragma unroll
        for (int i = 0; i < 4; ++i) { const int cc = (lane + 64 * i) * 4;
            float4 o; o.x = v[i].x * rs * cF[i].x; o.y = v[i].y * rs * cF[i].y; o.z = v[i].z * rs * cF[i].z; o.w = v[i].w * rs * cF[i].w;
            *(float4*)(p.out + (size_t)row * D + cc) = o; }
    }
}
__device__ __forceinline__ void ph_norm2_route(const P& p, int l, int Tm, LAS unsigned char* lds, int G, int c, int* cntp, bf16_t* h2c, int* list, int* rowidx, float* sroww) {
    constexpr int HST = 1028;
    const int t_ = otid(), w = t_ >> 6, lane = t_ & 63, r32 = lane & 31, hi = lane >> 5;
    LAS float* hs = (LAS float*)lds;
    LAS float* part = (LAS float*)(lds + 24 * HST * 4);
    LAS int* cnt_l = (LAS int*)(lds + 24 * HST * 4 + 32768);
    LAS int* base_l = cnt_l + 32;
    LAS int* sv_e = base_l + 32;
    LAS int* sv_r = sv_e + 512; LAS float* sv_w = (LAS float*)(sv_r + 512);
    const float* g = p.nfg + l * D;
    const int RPB = (Tm + G - 1) / G, nchunk = (RPB + 23) / 24;
    const int e = lane & 31;
    const float brt = p.b_router[l * NEXP + e];
    bf16x8 bh[8], bl[8];
    { const bf16_t* wh = p.WrH() + ((size_t)l * NEXP + r32) * D + w * 128 + hi * 8; const bf16_t* wl = p.WrL() + ((size_t)l * NEXP + r32) * D + w * 128 + hi * 8;
#pragma unroll
      for (int ks = 0; ks < 8; ++ks) { bh[ks] = *(const bf16x8*)(wh + ks * 16); bl[ks] = *(const bf16x8*)(wl + ks * 16); } }
    int cm = -1; float4 cA[4], cB[4];
#pragma unroll
    for (int i = 0; i < 4; ++i) { cA[i] = make_float4(0.f, 0.f, 0.f, 0.f); cB[i] = cA[i]; }
    if (t_ < 32) cnt_l[t_] = 0;
    for (int ch = 0; ch < nchunk; ++ch) {
        int rowj[3]; bool okj[3];
#pragma unroll
        for (int j = 0; j < 3; ++j) { const int ri = ch * 24 + w * 3 + j; rowj[j] = c * RPB + ri; okj[j] = (ri < RPB) && (rowj[j] < Tm);
            LAS float* hrow = hs + (w * 3 + j) * HST;
            if (okj[j]) { const int row = rowj[j];
                float4 v[4]; float ss = 0.f;
#pragma unroll
                for (int i = 0; i < 4; ++i) { v[i] = ldx4(p.X() + (size_t)row * D + (lane + 64 * i) * 4); ss += v[i].x * v[i].x + v[i].y * v[i].y + v[i].z * v[i].z + v[i].w * v[i].w; }
                ss = wave_sum(ss); const float rs = rsqrtf(ss * (1.f / D) + EPS);
                const int m = modidx(row);
                if (m != cm) { cm = m; const float* md = p.MOD() + (size_t)(l * 9 + m) * NMOD;
#pragma unroll
                    for (int i = 0; i < 4; ++i) { const int cc = (lane + 64 * i) * 4; const float4 gg = *(const float4*)(g + cc), sh = *(const float4*)(md + 3 * D + cc), sc = *(const float4*)(md + 4 * D + cc);
                        cA[i] = make_float4(gg.x * (1.f + sc.x), gg.y * (1.f + sc.y), gg.z * (1.f + sc.z), gg.w * (1.f + sc.w)); cB[i] = sh; } }
#pragma unroll
                for (int i = 0; i < 4; ++i) { const int cc = (lane + 64 * i) * 4;
                    f32x4 h; h[0] = v[i].x * rs * cA[i].x + cB[i].x; h[1] = v[i].y * rs * cA[i].y + cB[i].y; h[2] = v[i].z * rs * cA[i].z + cB[i].z; h[3] = v[i].w * rs * cA[i].w + cB[i].w;
                    *(LAS f32x4*)(hrow + cc) = h; uint2 hw; hw.x = cvt_pk_bf16(h[0], h[1]); hw.y = cvt_pk_bf16(h[2], h[3]); *(uint2*)(h2c + (size_t)row * D + cc) = hw; } }
            else {
#pragma unroll
                for (int i = 0; i < 4; ++i) *(LAS f32x4*)(hrow + (lane + 64 * i) * 4) = (f32x4){0.f, 0.f, 0.f, 0.f}; } }
        __syncthreads();
        { f32x16 acc;
#pragma unroll
          for (int r = 0; r < 16; ++r) acc[r] = 0.f;
          const LAS float* hp = hs + (r32 < 24 ? r32 : 23) * HST + w * 128 + hi * 8;
#pragma unroll
          for (int ks = 0; ks < 8; ++ks) { const f32x4 x0 = *(const LAS f32x4*)(hp + ks * 16), x1 = *(const LAS f32x4*)(hp + ks * 16 + 4);
              const unsigned h01 = cvt_pk_bf16(x0[0], x0[1]), h23 = cvt_pk_bf16(x0[2], x0[3]), h45 = cvt_pk_bf16(x1[0], x1[1]), h67 = cvt_pk_bf16(x1[2], x1[3]);
              const unsigned l01 = cvt_pk_bf16(x0[0] - __uint_as_float(h01 << 16), x0[1] - __uint_as_float(h01 & 0xffff0000u)), l23 = cvt_pk_bf16(x0[2] - __uint_as_float(h23 << 16), x0[3] - __uint_as_float(h23 & 0xffff0000u));
              const unsigned l45 = cvt_pk_bf16(x1[0] - __uint_as_float(h45 << 16), x1[1] - __uint_as_float(h45 & 0xffff0000u)), l67 = cvt_pk_bf16(x1[2] - __uint_as_float(h67 << 16), x1[3] - __uint_as_float(h67 & 0xffff0000u));
              const bf16x8 ah = __builtin_bit_cast(bf16x8, (u32x4){h01, h23, h45, h67}), al = __builtin_bit_cast(bf16x8, (u32x4){l01, l23, l45, l67});
              acc = __builtin_amdgcn_mfma_f32_32x32x16_bf16(ah, bh[ks], acc, 0, 0, 0);
              acc = __builtin_amdgcn_mfma_f32_32x32x16_bf16(al, bh[ks], acc, 0, 0, 0);
              acc = __builtin_amdgcn_mfma_f32_32x32x16_bf16(ah, bl[ks], acc, 0, 0, 0); }
          LAS float* pw_ = part + w * 1024 + r32;
#pragma unroll
          for (int r = 0; r < 16; ++r) pw_[crow(r, hi) * 32] = acc[r]; }
        __syncthreads();
#pragma unroll
        for (int j = 0; j < 3; ++j) {
            float logit = brt;
#pragma unroll
            for (int q = 0; q < 8; ++q) logit += part[q * 1024 + (w * 3 + j) * 32 + e];
            float tv0, tv1, tv2, tv3; int ti0, ti1, ti2, ti3;
#define TOP_DPP(CTRL) { const float ov = dppf<CTRL>(bv); const int oi = dppi<CTRL>(bi); if (ov > bv || (ov == bv && oi < bi)) { bv = ov; bi = oi; } }
#define TOP1(TV, TI) { float bv = logit; int bi = e; \
            TOP_DPP(0xB1) TOP_DPP(0x4E) TOP_DPP(0x141) TOP_DPP(0x140) \
            { const dpp_u32x2_t rv = __builtin_amdgcn_permlane16_swap(__float_as_uint(bv), __float_as_uint(bv), false, false), ri = __builtin_amdgcn_permlane16_swap((unsigned)bi, (unsigned)bi, false, false); \
              float av = __uint_as_float(rv.x); int ai_ = (int)ri.x; const float cv = __uint_as_float(rv.y); const int ci = (int)ri.y; if (cv > av || (cv == av && ci < ai_)) { av = cv; ai_ = ci; } bv = av; bi = ai_; } \
            TV = bv; TI = bi; if (e == bi) logit = -INFINITY; }
            TOP1(tv0, ti0) TOP1(tv1, ti1) TOP1(tv2, ti2) TOP1(tv3, ti3)
#undef TOP1
#undef TOP_DPP
            const float e1 = expf(tv1 - tv0), e2 = expf(tv2 - tv0), e3 = expf(tv3 - tv0); const float inv = 1.f / (1.f + e1 + e2 + e3);
            int ee = ti0; float ww = inv;
            if (lane == 1) { ee = ti1; ww = e1 * inv; } if (lane == 2) { ee = ti2; ww = e2 * inv; } if (lane == 3) { ee = ti3; ww = e3 * inv; }
            if (lane < 4 && okj[j]) { const int rk = __hip_atomic_fetch_add(cnt_l + ee, 1, __ATOMIC_RELAXED, __HIP_MEMORY_SCOPE_WORKGROUP); const int si = (ch * 24 + w * 3 + j) * 4 + lane; sv_e[si] = ee; sv_r[si] = rk; sv_w[si] = ww; }
        }
    }
    __syncthreads();
    if (t_ < 32) { const int n = cnt_l[t_]; base_l[t_] = n ? atomicAdd(&cntp[t_], n) : 0; }
    __syncthreads();
    for (int i = t_; i < RPB * 4; i += 512) { const int row = c * RPB + (i >> 2);
        if (row < Tm) { const int ee = sv_e[i], myrow = ee * CAP + base_l[ee] + sv_r[i]; rowidx[row * 4 + (i & 3)] = myrow; sroww[myrow] = sv_w[i]; list[myrow] = row; } }
}

struct CvtTile { const float* s; bf16_t* d; int ldsrc, Kdim; };
template <class F>
__device__ __forceinline__ void cvt_run(const F& tile_of, int first, int stride, int n, LAS unsigned char* lds) {
    const int tid = otid(), lane = tid & 63, w = tid >> 6;
    LAS float* tl = (LAS float*)lds + w * (64 * 33);
    if (n <= 0) return;
    const int lr = lane >> 3, lc = lane & 7;
    float4 va[8], vb[8];
    CvtTile ta = tile_of(first), tb = ta;
#define CVT_LD(V, T_) do { _Pragma("unroll") for (int i = 0; i < 8; ++i) { const f32x4 q_ = __builtin_nontemporal_load((const f32x4*)((T_).s + (size_t)(i * 8 + lr) * (T_).ldsrc + w * 32 + lc * 4)); V[i] = make_float4(q_[0], q_[1], q_[2], q_[3]); } } while (0)
#define CVT_W(V) do { _Pragma("unroll") for (int i = 0; i < 8; ++i) { LAS float* t = tl + (i * 8 + lr) * 33 + lc * 4; t[0] = V[i].x; t[1] = V[i].y; t[2] = V[i].z; t[3] = V[i].w; } } while (0)
#define CVT_R(T_) do { __builtin_amdgcn_s_waitcnt(0xc07f); \
        _Pragma("unroll") for (int i = 0; i < 4; ++i) { const int nn = i * 8 + lr; float a[8]; \
            _Pragma("unroll") for (int jj = 0; jj < 8; ++jj) a[jj] = tl[(lc * 8 + jj) * 33 + nn]; \
            u32x4 wv; wv.x = cvt_pk_bf16(a[0], a[1]); wv.y = cvt_pk_bf16(a[2], a[3]); wv.z = cvt_pk_bf16(a[4], a[5]); wv.w = cvt_pk_bf16(a[6], a[7]); \
            __builtin_nontemporal_store(wv, (u32x4*)((T_).d + (size_t)(w * 32 + nn) * (T_).Kdim + lc * 8)); } \
        __builtin_amdgcn_s_waitcnt(0xc07f); } while (0)
    CVT_LD(va, ta);
    if (n > 1) { tb = tile_of(first + stride); CVT_LD(vb, tb); }
    for (int it = 0; it < n; it += 2) {
        { const CvtTile done_ = ta; CVT_W(va);
          if (it + 2 < n) { ta = tile_of(first + (it + 2) * stride); CVT_LD(va, ta); }
          CVT_R(done_); }
        if (it + 1 < n) { const CvtTile done_ = tb; CVT_W(vb);
          if (it + 3 < n) { tb = tile_of(first + (it + 3) * stride); CVT_LD(vb, tb); }
          CVT_R(done_); }
    }
#undef CVT_LD
#undef CVT_W
#undef CVT_R
    __syncthreads();
}
struct SmallTiles { P p;
    __device__ __forceinline__ CvtTile operator()(int t) const { CvtTile r;
        if (t < 1536) { const int part = t / 768, u = t - part * 768, l = u / 192, rem = u - l * 192, ky = rem / 12, nx = rem - ky * 12;
            r.s = p.w_in + ((size_t)l * D + ky * 64) * INC + (part ? 3584 : 0) + nx * 256; r.d = p.WinT() + ((size_t)l * 7168 + (part ? 4096 : 0) + nx * 256) * D + ky * 64; r.ldsrc = INC; r.Kdim = D; }
        else if (t < 1920) { const int u = t - 1536, lb = u / 32, rem = u - lb * 32, ky = rem / 4, nx = rem - ky * 4;
            r.s = p.w_branch + ((size_t)lb * 512 + ky * 64) * D + nx * 256; r.d = p.WbT() + ((size_t)lb * D + nx * 256) * 512 + ky * 64; r.ldsrc = D; r.Kdim = 512; }
        else { const int u = t - 1920, l = u / 64, rem = u - l * 64, ky = rem / 4, nx = rem - ky * 4;
            r.s = p.w_out + ((size_t)l * D + ky * 64) * D + nx * 256; r.d = p.WoT() + ((size_t)l * D + nx * 256) * D + ky * 64; r.ldsrc = D; r.Kdim = D; }
        return r; } };
struct MoeTiles { P p; int l;
    __device__ __forceinline__ CvtTile operator()(int t) const { CvtTile r;
        if (t < 4096) { const int e = t >> 7, rem = t & 127, ky = rem >> 3, nx = rem & 7; const size_t le = (size_t)l * NEXP + e;
            r.s = p.w_gu + (le * D + ky * 64) * 2048 + nx * 256; r.d = p.WguT() + (le * 2048 + nx * 256) * D + ky * 64; r.ldsrc = 2048; r.Kdim = D; }
        else { const int u = t - 4096, e = u >> 6, rem = u & 63, ky = rem >> 2, nx = rem & 3; const size_t le = (size_t)l * NEXP + e;
            r.s = p.w_dn + (le * D + ky * 64) * D + nx * 256; r.d = p.WdT() + (le * D + nx * 256) * D + ky * 64; r.ldsrc = D; r.Kdim = D; }
        return r; } };
constexpr int MOE_CVT_BATCH = 8, MOE_CVT_NB = 6144 / MOE_CVT_BATCH;
constexpr int CVT_RESERVE = 256, MOE_CVT_FRONT = MOE_CVT_NB - CVT_RESERVE;
__device__ __forceinline__ void ph_prologue(const P& p, LAS unsigned char* lds, int G, int c) {
    const int tid = otid(); const size_t gt = (size_t)c * 512 + tid, gs = (size_t)G * 512;
    if (c == 0 && tid < 256) { const int l = tid >> 6, lane = tid & 63; const float* d = p.da_lambda + l * 256;
        const float a = wave_sum(d[lane] * d[64 + lane]), b = wave_sum(d[128 + lane] * d[192 + lane]);
        if (lane == 0) p.LAM()[l] = expf(a) - expf(b) + (0.8f - 0.6f * expf(-0.3f * (float)l)); }
    for (size_t idx = gt; idx < (size_t)SEQ * 32; idx += gs) { const int s = (int)(idx >> 5), j = (int)(idx & 31), axis = j >> 4, i = j & 15;
        const float pos = axis == 0 ? (float)(s / 64) : (float)(s % 64); const float a = pos * powf(10000.f, -(float)i / 16.f);
        p.ROPE()[idx] = cosf(a); p.ROPE()[SEQ * 32 + idx] = sinf(a); }
    for (size_t idx = gt; idx < (size_t)512 * 512; idx += gs) { const int R = (int)(idx >> 9), k = (int)(idx & 511), t = R >> 8, r = R & 255, im = r >> 7, k2 = 128 * t + (r & 127), n2 = k & 255;
        const float a = (float)((k2 * n2) & 255) / 128.f; const float cv = cospif(a), sv = sinpif(a);
        p.CSX()[idx] = f2bf(im ? (k < 256 ? sv : cv) : (k < 256 ? cv : -sv)); }
    for (size_t idx = gt; idx < (size_t)256 * 512; idx += gs) { const int r = (int)(idx >> 9), k = (int)(idx & 511), kk = k & 255, n = (kk >> 5) + 8 * (kk & 31), m = (r * n) & 255; const float a = (float)m / 128.f;
        p.CSY()[idx] = f2bf(k < 256 ? cospif(a) : -sinpif(a)); }
    for (size_t idx = gt; idx < (size_t)1024 * 512; idx += gs) { const int r = (int)(idx >> 9), cc = (int)(idx & 511), part = r >> 9, g = (r >> 7) & 3, j = r & 127, gc = cc >> 7, ci = cc & 127;
        const float a = (float)((j * ci) & 127) / 64.f; p.DFTC()[idx] = (gc == g) ? f2bf(part ? sinpif(a) : cospif(a)) : (bf16_t)0; }
    for (size_t idx = gt; idx < (size_t)DEPTH * NEXP * D; idx += gs) { const int k = (int)(idx & (D - 1)), e = (int)((idx >> 10) & (NEXP - 1)), l = (int)(idx >> 15);
        const float wv = p.w_router[((size_t)l * D + k) * NEXP + e]; const bf16_t h = f2bf(wv); p.WrH()[idx] = h; p.WrL()[idx] = f2bf(wv - bf2f(h)); }
    for (size_t idx = gt; idx < (size_t)DEPTH * D * 128; idx += gs) { const size_t lk = idx >> 7; const int c4 = (int)(idx & 127) * 4; const float4 v = *(const float4*)(p.w_in + lk * INC + 3072 + c4);
        ushort4 o; o.x = f2bf(v.x); o.y = f2bf(v.y); o.z = f2bf(v.z); o.w = f2bf(v.w); *(ushort4*)(p.Wf() + lk * 512 + c4) = o; }
    { LAS float* sc = (LAS float*)lds; LAS float* red = sc + 9 * 1024;
      for (int i = tid; i < 9 * 1024; i += 512) { const int r = i >> 10, k = i & 1023; const float v = r < 8 ? p.c[r * 1024 + k] : p.c_ctx[k]; sc[i] = v / (1.f + expf(-v)); }
      __syncthreads();
      for (int it = c; it < DEPTH * 96; it += G) { const int l = it / 96, cg = it - l * 96, kg = tid >> 6, lane = tid & 63, sub = lane >> 4, c4 = (lane & 15) * 4;
          float acc[9][4];
#pragma unroll
          for (int r = 0; r < 9; ++r) { acc[r][0] = 0.f; acc[r][1] = 0.f; acc[r][2] = 0.f; acc[r][3] = 0.f; }
          const float* w = p.w_mod + (size_t)l * 1024 * NMOD + cg * 64 + c4;
#pragma unroll 8
          for (int kk = 0; kk < 32; ++kk) { const int k = kg * 128 + kk * 4 + sub; const float4 wv = *(const float4*)(w + (size_t)k * NMOD);
#pragma unroll
              for (int r = 0; r < 9; ++r) { const float sv = sc[r * 1024 + k]; acc[r][0] += sv * wv.x; acc[r][1] += sv * wv.y; acc[r][2] += sv * wv.z; acc[r][3] += sv * wv.w; } }
#pragma unroll
          for (int r = 0; r < 9; ++r)
#pragma unroll
              for (int j = 0; j < 4; ++j) { float v = acc[r][j]; v += __shfl_xor(v, 16); v += __shfl_xor(v, 32); if (sub == 0) red[(kg * 9 + r) * 64 + c4 + j] = v; }
          __syncthreads();
          for (int i = tid; i < 9 * 64; i += 512) { const int r = i >> 6, cc = i & 63, nn = cg * 64 + cc; float s = p.b_mod[l * NMOD + nn];
#pragma unroll
              for (int q = 0; q < 8; ++q) s += red[(q * 9 + r) * 64 + cc];
              p.MOD()[(size_t)(l * 9 + r) * NMOD + nn] = s; }
          __syncthreads(); } }
    { SmallTiles st{p}; const int n = (2176 - c + G - 1) / G; cvt_run(st, c, G, n, lds); }
}
struct GFuse {
    static constexpr bool PERM = true, GATHER = false, PRE = false;
    P p; int lda, ldb, K, G, c, pad;
    __device__ __forceinline__ bool next(int i, GUnit& u) const {
        const int L = i * G + c; if (L >= 64) return false;
        const int l = L >> 4, pm = (L >> 2) & 3, pn = L & 3; u.pm = pm; u.pn = pn; u.e = l; u.pad = 0;
        u.a0 = (const char*)(p.DFTC() + (size_t)pm * 256 * 512); u.a1 = u.a0 + (size_t)HALF * 512 * 2;
        u.b0 = (const char*)(p.Wf() + ((size_t)l * D + pn * 256) * 512); u.b1 = u.b0 + (size_t)HALF * 512 * 2; return true; }
    __device__ __forceinline__ bool epi(f32x4 (&acc)[2][2][4][2], const GUnit& u, int wr, int wc, int fr, int fq) const {
        const int row0 = u.pm * 256 + wr * 64 + fr;
#pragma unroll
        for (int ai = 0; ai < 2; ++ai)
#pragma unroll
            for (int m = 0; m < 4; ++m) { const int row = row0 + ai * HALF + m * 16;
#pragma unroll
                for (int bj = 0; bj < 2; ++bj) { const f32x4 v0 = acc[ai][bj][m][0], v1 = acc[ai][bj][m][1]; const int col0 = u.pn * 256 + bj * HALF + wc * 32 + 8 * fq;
                    u32x4 w; w.x = cvt_pk_bf16(v0[0], v0[1]); w.y = cvt_pk_bf16(v0[2], v0[3]); w.z = cvt_pk_bf16(v1[0], v1[1]); w.w = cvt_pk_bf16(v1[2], v1[3]);
                    *(u32x4*)(p.WinT() + ((size_t)u.e * 7168 + 3072 + row) * D + col0) = w; } }
        return false;
    }
};

__device__ __forceinline__ void unit_signal(int* ctr) {
    asm volatile("s_waitcnt vmcnt(0)" ::: "memory");
    __syncthreads();
    if (threadIdx.x == 0) { __builtin_amdgcn_fence(__ATOMIC_RELEASE, "agent"); asm volatile("s_waitcnt vmcnt(0)" ::: "memory");
        (void)__hip_atomic_fetch_add(ctr, 1, __ATOMIC_RELAXED, __HIP_MEMORY_SCOPE_AGENT); }
}
__device__ __forceinline__ void unit_wait(int* ctr, int need, unsigned* bar) {
    if (threadIdx.x == 0) { unsigned sp = 0;
        while (__hip_atomic_load(ctr, __ATOMIC_RELAXED, __HIP_MEMORY_SCOPE_AGENT) < need) { __builtin_amdgcn_s_sleep(2);
            if ((++sp & 255u) == 0u) { if (xb_ld(&bar[XB_TMO])) break; if (sp > (1u << 20)) { atomicAdd(&bar[XB_TMO], 1u); break; } } }
        __builtin_amdgcn_fence(__ATOMIC_ACQUIRE, "agent"); asm volatile("s_waitcnt vmcnt(0)" ::: "memory"); }
    __syncthreads();
}
__device__ __forceinline__ int grab(int* ctr, volatile LAS int* slot) {
    __syncthreads();
    if (threadIdx.x == 0) *slot = atomicAdd(ctr, 1);
    __syncthreads();
    return __builtin_amdgcn_readfirstlane(*slot);
}
__device__ __forceinline__ int grab_xcd(int* qx, int x, int nper, volatile LAS int* slot) {
    __syncthreads();
    if (threadIdx.x == 0) { int r = -1;
        for (int k = 0; k < 8; ++k) { const int xx = (x + k) & 7;
            if (__hip_atomic_load(qx + xx * 16, __ATOMIC_RELAXED, __HIP_MEMORY_SCOPE_AGENT) >= nper) continue;
            const int v = atomicAdd(qx + xx * 16, 1); if (v < nper) { r = xx * nper + v; break; } }
        *slot = r; }
    __syncthreads();
    return __builtin_amdgcn_readfirstlane(*slot);
}
typedef __attribute__((address_space(4))) const P* kparg_t;
__device__ __forceinline__ P load_p() {
#if defined(__HIP_DEVICE_COMPILE__)
    kparg_t kp = (kparg_t)__builtin_amdgcn_kernarg_segment_ptr(); asm volatile("" : "+s"(kp)); return *kp;
#else
    return P{};
#endif
}
#define XBAR(b) do { for (int rb_ = 0; rb_ < REP_BAR; ++rb_) xcd_barrier(b); } while (0)
__global__ __launch_bounds__(512, 2) __attribute__((amdgpu_waves_per_eu(2, 2))) void mega(P p_unused) {
    LAS unsigned char* lds = (LAS unsigned char*)dyn_smem;
    const int G = (int)gridDim.x, c = (int)blockIdx.x;
    volatile LAS unsigned* st = (volatile LAS unsigned*)(lds + LDS_BARW);
    volatile LAS int* slot = (volatile LAS int*)(lds + LDS_BARW + 8);
    if (threadIdx.x == 0) { st[0] = 0u; st[1] = 0u; st[2] = 0u; st[3] = 0u; }
    __syncthreads();
    const XcdBarrier bar = xcd_barrier_post(load_p().bar(), st);
    for (int rep = 0; rep < REP_PRO; ++rep) { const P p = load_p(); ph_prologue(p, lds, G, c);
    XBAR(bar); }
    { const P p = load_p(); GFuse g{p, 512, 512, 512, G, c, 0}; gemm_phase(lds, g); }
    XBAR(bar);
    for (int l = 0; l < DEPTH; ++l) {
        const bool last = (l == DEPTH - 1); const int Tm = last ? TX : T;
        for (int rep = 0; rep < REP_N1; ++rep) { const P p = load_p(); ph_norm1(p, l, G, c, rep == 0 ? 1.f : 0.f);
        XBAR(bar); }
        for (int rep = 0; rep < REP_INP; ++rep) { { const P p = load_p(); GInproj g{p, l, D, D, D, G, c}; gemm_phase(lds, g); }
        XBAR(bar); }
        { const P p = load_p(); int* q = p.QCTR() + l * 16; int* sig = p.SIG() + l * 9 * 32; unsigned* barw = p.bar(); int u; const int xq = (int)(bar.x & 7u);
          const MoeTiles mt_{p, l};
          if ((c & 3) == 0) { while ((u = grab(q + 5, slot)) < MOE_CVT_FRONT) cvt_run(mt_, u * MOE_CVT_BATCH, 1, MOE_CVT_BATCH, lds); }
          if (!last) {
              while ((u = grab(q + 3, slot)) < 16) { GFourY g{p, 512, 512, 512, u, 0, 0}; gemm_phase(lds, g); unit_signal(sig); }
              while ((u = grab(q + 4, slot)) < 64) { const int b = u >> 3, h = u & 7; attn_unit_seq<2>(p, l, lds, h, TX + b * CTX, TX + b * CTX, 4, 0, 0, 0, 0); unit_signal(sig); }
              while ((u = grab(q + 6, slot)) < 64) { const int b = u >> 3, h = (u >> 1) & 3, qb = u & 1; attn_unit<0>(p, l, lds, h, TX + b * CTX + qb * 128, TX + b * CTX, 4, 0, 0, 0, 0); unit_signal(sig); } }
          while ((u = grab(q + 0, slot)) < 256 * REP_FX) { GFourX g{p, 512, 512, 512, u & 255, 0, 0}; gemm_phase(lds, g); }
          if (!last) { while ((u = grab(q + 7, slot)) < 32) { unit_wait(sig, 144, barw); GMerge g{p, l, 64, 1536, 512, 512, G, c, u}; gemm_phase(lds, g); unit_signal(sig + 32 * (1 + (u >> 2))); } }
          while ((u = grab_xcd(p.XQ() + (l * 2 + 0) * 128, xq, 64 * REP_DA, slot)) >= 0) { const int pr = u / (64 * REP_DA) + 8 * ((u >> 4) & 3), b = pr >> 2, h = pr & 3, qb = u & 15;
              attn_unit<0>(p, l, lds, h, b * SEQ + qb * 128, b * SEQ, 32, TX + b * CTX, 4, 0, 0); }
          while ((u = grab_xcd(p.XQ() + (l * 2 + 1) * 128, xq, 64 * REP_NA, slot)) >= 0) { const int pr = u / (64 * REP_NA) + 8 * ((u >> 3) & 7), b = pr >> 3, h = pr & 7, R0 = (u & 7) * 4;
              const int j0 = min(max(R0 - 4, 0), 24), je = min(max(R0 - 1, 0), 24) + 8;
              attn_unit_seq<1>(p, l, lds, h, b * SEQ + R0 * 64, b * SEQ + j0 * 64, je - j0, TX + b * CTX, 4, R0, j0); }
          if (!last) { while ((u = grab(q + 8, slot)) < 32) { unit_wait(sig + 32 * (1 + (u >> 2)), 4, barw); GOut g{p, l, 64, D, D, D, G, c, u, 1.f, 0}; gemm_phase(lds, g); } }
          while ((u = grab(q + 5, slot)) < MOE_CVT_FRONT) cvt_run(mt_, u * MOE_CVT_BATCH, 1, MOE_CVT_BATCH, lds);
          while ((u = grab(q + 11, slot)) < CVT_RESERVE) cvt_run(mt_, (MOE_CVT_FRONT + u) * MOE_CVT_BATCH, 1, MOE_CVT_BATCH, lds);
        XBAR(bar); }
        { { const P p = load_p(); GMerge g{p, l, 64, 1536, 512, 512, G, c, -1}; gemm_phase(lds, g); }
        XBAR(bar); }
        { { const P p = load_p(); GOut g{p, l, 64, D, D, D, G, c, -1, 1.f, 0}; gemm_phase(lds, g); }
        XBAR(bar); }
        for (int rep = 0; rep < REP_N2; ++rep) { const P p = load_p(); if (rep == 0) ph_norm2_route(p, l, Tm, lds, G, c, p.CNT() + l * NEXP, p.H1(), p.LIST(), p.ROWIDX(), p.SROWW()); else ph_norm2_route(p, l, Tm, lds, G, c, p.CNT() + 128 + l * NEXP, p.ACT(), (int*)p.Mf() + (size_t)T * 8, (int*)p.Mf(), p.Mf() + (size_t)T * 4);
        XBAR(bar); }
        for (int rep = 0; rep < REP_GU; ++rep) { const P p = load_p(); LAS int* mtb = (LAS int*)(lds + LDS_SCRATCH); moe_tiles(p, l, mtb); GGateUp g{p, mtb, l, D, D, D, G, c, (rep > 0 && REP_GU_CHEAP) ? 1 : 0, 0}; gemm_phase(lds, g);
          if (TAIL_CVT && l + 1 < DEPTH) { const int U = mtb[NEXP] * 8; if ((U - c + G - 1) / G < (U + G - 1) / G) { const MoeTiles mt2{p, l + 1}; const int u2 = grab(p.QCTR() + (l + 1) * 16 + 5, slot); if (u2 < MOE_CVT_FRONT) cvt_run(mt2, u2 * MOE_CVT_BATCH, 1, MOE_CVT_BATCH, lds); } }
        XBAR(bar); }
        for (int rep = 0; rep < REP_DN; ++rep) { const P p = load_p(); LAS int* mtb = (LAS int*)(lds + LDS_SCRATCH); moe_tiles(p, l, mtb); GDown g{p, mtb, l, D, D, D, G, c}; gemm_phase(lds, g);
          if (TAIL_CVT && l + 1 < DEPTH) { const int U = mtb[NEXP] * 4; if ((U - c + G - 1) / G < (U + G - 1) / G) { const MoeTiles mt2{p, l + 1}; const int u2 = grab(p.QCTR() + (l + 1) * 16 + 5, slot); if (u2 < MOE_CVT_FRONT) cvt_run(mt2, u2 * MOE_CVT_BATCH, 1, MOE_CVT_BATCH, lds); } }
        XBAR(bar); }
    }
    { const P p = load_p(); ph_final(p, G, c); }
}

extern "C" void kernel_launch(void* const* d_in, const int* in_sizes, int n_in, void* d_out, int out_size, void* d_ws, size_t ws_size, hipStream_t stream) {
    P p{};
    p.x = (const float*)d_in[0]; p.c = (const float*)d_in[1]; p.ctx = (const float*)d_in[2]; p.c_ctx = (const float*)d_in[3]; p.w_mod = (const float*)d_in[4]; p.b_mod = (const float*)d_in[5];
    p.nmg = (const float*)d_in[6]; p.nfg = (const float*)d_in[7]; p.w_in = (const float*)d_in[8]; p.da_lambda = (const float*)d_in[9]; p.da_subln_g = (const float*)d_in[10]; p.na_rpb = (const float*)d_in[11];
    p.w_branch = (const float*)d_in[12]; p.w_out = (const float*)d_in[13]; p.w_router = (const float*)d_in[14]; p.b_router = (const float*)d_in[15]; p.w_gu = (const float*)d_in[16]; p.b_gu = (const float*)d_in[17];
    p.w_dn = (const float*)d_in[18]; p.b_dn = (const float*)d_in[19]; p.final_g = (const float*)d_in[20]; p.out = (float*)d_out;
    p.ws = (char*)d_ws;
    if (WS_NEED > ws_size) { fprintf(stderr, "workspace too small: need %zu have %zu\n", (size_t)WS_NEED, ws_size); return; }
    static int grid = 0;
    if (!grid) {
        (void)hipFuncSetAttribute((const void*)mega, hipFuncAttributeMaxDynamicSharedMemorySize, LDS_TOTAL);
        int dev = 0, cus = 0, per_cu = 0; (void)hipGetDevice(&dev); (void)hipDeviceGetAttribute(&cus, hipDeviceAttributeMultiprocessorCount, dev);
        (void)hipOccupancyMaxActiveBlocksPerMultiprocessor(&per_cu, (const void*)mega, 512, LDS_TOTAL);
        grid = (per_cu >= 1) ? (cus / 8) * 8 : 0; if (grid > 256) grid = 256;
        if (grid <= 0) { fprintf(stderr, "mega: no resident grid (cus %d per_cu %d)\n", cus, per_cu); grid = 0; return; }
    }
    (void)hipMemsetAsync(p.ws + OFF_CTL, 0, SZ_CTL, stream);
    mega<<<grid, 512, LDS_TOTAL, stream>>>(p);
}
```
